# Optimizing an MI355X kernel written in HIP

```python
import jax, jax.numpy as jnp
from jax import lax
import numpy as np

D_MODEL = 2048
BATCH = 4
SEQ = 2048
DEPTH = 1
DEC_BATCH = 128
DEC_SEQ = 4
PAST_LEN = 16384
PAGE_SIZE = 128

D_MIX = D_MODEL
D_CONV = D_MIX // 2
N_CONV_GROUPS = 8
CONV_A_WIDTH = 3
DN_HEADS = 8
DN_DK = 128
DN_DV = (D_MIX - D_CONV) // DN_HEADS
DN_QK = DN_HEADS * DN_DK
DN_V = DN_HEADS * DN_DV
DN_CONV_WIDTH = 4
DN_QKV = 2 * DN_QK + DN_V
CHUNK = 64
D_FF = 5632
D_PLE = 256
EPS = 1e-6
COL_SIZES = [D_CONV, D_CONV, D_CONV, DN_QK, DN_QK, DN_V, DN_V, DN_HEADS, DN_HEADS]
COL_OFFSETS = [int(o) for o in np.cumsum(COL_SIZES)[:-1]]
IN_COLS = int(sum(COL_SIZES))

kernel_name = "hymba_conv_gdn_macaron_step"


def rmsnorm(x, g):
    xf = x.astype(jnp.float32)
    y = xf * lax.rsqrt(jnp.mean(xf * xf, axis=-1, keepdims=True) + EPS)
    return (y * g.astype(jnp.float32)).astype(x.dtype)


def l2norm(x):
    return x * lax.rsqrt(jnp.sum(x * x, axis=-1, keepdims=True) + EPS)


def swiglu(x, wg, wu, wd):
    return (jax.nn.silu(x @ wg) * (x @ wu)) @ wd


def causal_dwconv(u, buf, w):
    T = u.shape[1]
    W = w.shape[0]
    full = jnp.concatenate([buf.astype(u.dtype), u], axis=1)
    y = full[:, 0:T] * w[0]
    for j in range(1, W):
        y = y + full[:, j:j + T] * w[j]
    return y, full[:, -(W - 1):]


def gated_delta_chunked(q, k, v, g, beta, s0):
    Bn, T, H, Dk = q.shape
    Dv = v.shape[-1]
    C = CHUNK if T >= CHUNK else T
    pad = (-T) % C
    if pad:
        pw = ((0, 0), (0, pad), (0, 0), (0, 0))
        q, k, v = jnp.pad(q, pw), jnp.pad(k, pw), jnp.pad(v, pw)
        g, beta = jnp.pad(g, pw[:3]), jnp.pad(beta, pw[:3])
    N = (T + pad) // C

    def chunks(a):
        a = a.reshape((Bn, N, C, H) + a.shape[3:])
        return jnp.moveaxis(a, (1, 3), (0, 2))

    qc, kc, vc = chunks(q), chunks(k), chunks(v)
    gc = jnp.cumsum(chunks(g), axis=-1)
    bc = chunks(beta)
    causal = jnp.tril(jnp.ones((C, C), dtype=bool))
    strict = jnp.tril(jnp.ones((C, C), dtype=bool), -1)
    decay = jnp.exp(jnp.where(causal, gc[..., :, None] - gc[..., None, :], -jnp.inf))
    kb = kc * bc[..., None]
    a_mat = jnp.where(strict, jnp.einsum('nbhid,nbhjd->nbhij', kb, kc) * decay, 0.0)
    eye = jnp.eye(C, dtype=jnp.float32)
    t_mat = lax.linalg.triangular_solve(a_mat + eye, jnp.broadcast_to(eye, a_mat.shape),
                                        left_side=True, lower=True, unit_diagonal=True)
    w = jnp.einsum('nbhij,nbhjd->nbhid', t_mat, kb * jnp.exp(gc)[..., None])
    u = jnp.einsum('nbhij,nbhjd->nbhid', t_mat, vc * bc[..., None])
    qk = jnp.where(causal, jnp.einsum('nbhid,nbhjd->nbhij', qc, kc) * decay, 0.0)

    def step(S, inp):
        q_i, k_i, u_i, w_i, qk_i, g_i = inp
        v_new = u_i - jnp.einsum('bhck,bhkv->bhcv', w_i, S)
        o_i = (jnp.einsum('bhck,bhkv->bhcv', q_i * jnp.exp(g_i)[..., None], S)
               + jnp.einsum('bhij,bhjv->bhiv', qk_i, v_new))
        g_last = g_i[..., -1:]
        S = (S * jnp.exp(g_last)[..., None]
             + jnp.einsum('bhck,bhcv->bhkv', k_i * jnp.exp(g_last - g_i)[..., None], v_new))
        return S, o_i

    s_fin, o = lax.scan(step, s0, (qc, kc, u, w, qk, gc))
    o = jnp.moveaxis(o, (0, 2), (1, 3)).reshape(Bn, N * C, H, Dv)[:, :T]
    return o, s_fin


def mixing(h, conv_a_buf, qkv_buf, s0, w_in, conv_a_w, conv_qkv_w, a_log, dt_bias, dn_norm, w_out):
    Bn, T, _ = h.shape
    proj = h @ w_in
    gb, gcv, hc, q, k, v, z, a, b = jnp.split(proj, COL_OFFSETS, axis=-1)
    cu, conv_a_new = causal_dwconv(gcv * hc, conv_a_buf, conv_a_w)
    y_a = gb * cu
    cqkv, qkv_new = causal_dwconv(jnp.concatenate([q, k, v], axis=-1), qkv_buf, conv_qkv_w)
    cqkv = jax.nn.silu(cqkv).astype(jnp.float32)
    q, k, v = jnp.split(cqkv, [DN_QK, 2 * DN_QK], axis=-1)
    q = l2norm(q.reshape(Bn, T, DN_HEADS, DN_DK)) * (DN_DK ** -0.5)
    k = l2norm(k.reshape(Bn, T, DN_HEADS, DN_DK))
    v = v.reshape(Bn, T, DN_HEADS, DN_DV)
    g = -jnp.exp(a_log.astype(jnp.float32)) * jax.nn.softplus(
        a.astype(jnp.float32) + dt_bias.astype(jnp.float32))
    beta = jax.nn.sigmoid(b.astype(jnp.float32))
    o, s_new = gated_delta_chunked(q, k, v, g, beta, s0.astype(jnp.float32))
    o = rmsnorm(o, dn_norm) * jax.nn.silu(z.astype(jnp.float32).reshape(Bn, T, DN_HEADS, DN_DV))
    y_b = o.reshape(Bn, T, DN_V).astype(h.dtype)
    out = jnp.concatenate([y_a, y_b], axis=-1) @ w_out
    return out, conv_a_new, qkv_new, s_new.astype(h.dtype)


def layer_forward(x, p, conv_a_buf, qkv_buf, s0, lw):
    (f1_pre, f1_post, f1_wg, f1_wu, f1_wd,
     mix_pre, mix_post, w_in, conv_a_w, conv_qkv_w, a_log, dt_bias, dn_norm, w_out,
     f2_pre, f2_post, f2_wg, f2_wu, f2_wd,
     ple_pre, ple_post, w_ple_gate, w_ple_proj) = lw
    x = x + 0.5 * rmsnorm(swiglu(rmsnorm(x, f1_pre), f1_wg, f1_wu, f1_wd), f1_post)
    m, ca, cq, s = mixing(rmsnorm(x, mix_pre), conv_a_buf, qkv_buf, s0, w_in, conv_a_w,
                          conv_qkv_w, a_log, dt_bias, dn_norm, w_out)
    x = x + rmsnorm(m, mix_post)
    x = x + 0.5 * rmsnorm(swiglu(rmsnorm(x, f2_pre), f2_wg, f2_wu, f2_wd), f2_post)
    gate = jax.nn.sigmoid(rmsnorm(x, ple_pre) @ w_ple_gate)
    x = x + rmsnorm(gate * (p.astype(x.dtype) @ w_ple_proj), ple_post)
    return x, ca, cq, s


def setup_inputs(seed: int = 0) -> dict:
    key = jax.random.key(seed)
    ks = iter(jax.random.split(key, 64))
    nrm = lambda shape, s=1.0: jax.random.normal(next(ks), shape, jnp.float32) * s
    gain = lambda n: 1.0 + 0.02 * jax.random.normal(next(ks), (DEPTH, n), jnp.float32)
    d = {}
    d["x_prompt"] = nrm((BATCH, SEQ, D_MODEL))
    d["x_sample"] = nrm((DEC_BATCH, DEC_SEQ, D_MODEL))
    d["state_conv_a"] = nrm((DEPTH, DEC_BATCH, CONV_A_WIDTH - 1, D_CONV))
    d["state_conv_qkv"] = nrm((DEPTH, DEC_BATCH, DN_CONV_WIDTH - 1, DN_QKV))
    d["state_delta"] = nrm((DEPTH, DEC_BATCH, DN_HEADS, DN_DK, DN_DV), 0.1)
    d["p_prompt"] = nrm((DEPTH, BATCH, SEQ, D_PLE))
    d["p_sample"] = nrm((DEPTH, DEC_BATCH, DEC_SEQ, D_PLE))
    for nm in ("f1",):
        d[nm + "_pre"] = gain(D_MODEL)
        d[nm + "_post"] = gain(D_MODEL)
        d[nm + "_wg"] = nrm((DEPTH, D_MODEL, D_FF), D_MODEL ** -0.5)
        d[nm + "_wu"] = nrm((DEPTH, D_MODEL, D_FF), D_MODEL ** -0.5)
        d[nm + "_wd"] = nrm((DEPTH, D_FF, D_MODEL), D_FF ** -0.5)
    d["mix_pre"] = gain(D_MODEL)
    d["mix_post"] = gain(D_MODEL)
    d["w_in"] = nrm((DEPTH, D_MODEL, IN_COLS), D_MODEL ** -0.5)
    d["conv_a_w"] = nrm((DEPTH, CONV_A_WIDTH, D_CONV), CONV_A_WIDTH ** -0.5)
    d["conv_qkv_w"] = nrm((DEPTH, DN_CONV_WIDTH, DN_QKV), DN_CONV_WIDTH ** -0.5)
    d["a_log"] = jnp.log(jax.random.uniform(next(ks), (DEPTH, DN_HEADS), jnp.float32, 1.0, 16.0))
    d["dt_bias"] = nrm((DEPTH, DN_HEADS), 0.1)
    d["dn_norm"] = gain(DN_DV)
    d["w_out"] = nrm((DEPTH, D_MIX, D_MODEL), D_MIX ** -0.5)
    for nm in ("f2",):
        d[nm + "_pre"] = gain(D_MODEL)
        d[nm + "_post"] = gain(D_MODEL)
        d[nm + "_wg"] = nrm((DEPTH, D_MODEL, D_FF), D_MODEL ** -0.5)
        d[nm + "_wu"] = nrm((DEPTH, D_MODEL, D_FF), D_MODEL ** -0.5)
        d[nm + "_wd"] = nrm((DEPTH, D_FF, D_MODEL), D_FF ** -0.5)
    d["ple_pre"] = gain(D_MODEL)
    d["ple_post"] = gain(D_MODEL)
    d["w_ple_gate"] = nrm((DEPTH, D_MODEL, D_MODEL), D_MODEL ** -0.5)
    d["w_ple_proj"] = nrm((DEPTH, D_PLE, D_MODEL), D_PLE ** -0.5)
    return d


def reference(x_prompt, x_sample, state_conv_a, state_conv_qkv, state_delta, p_prompt, p_sample,
              f1_pre, f1_post, f1_wg, f1_wu, f1_wd,
              mix_pre, mix_post, w_in, conv_a_w, conv_qkv_w, a_log, dt_bias, dn_norm, w_out,
              f2_pre, f2_post, f2_wg, f2_wu, f2_wd,
              ple_pre, ple_post, w_ple_gate, w_ple_proj):
    yp, ys = x_prompt, x_sample
    bp = x_prompt.shape[0]
    ca_p, cq_p, s_p, ca_s, cq_s, s_s = [], [], [], [], [], []
    for i in range(DEPTH):
        lw = (f1_pre[i], f1_post[i], f1_wg[i], f1_wu[i], f1_wd[i],
              mix_pre[i], mix_post[i], w_in[i], conv_a_w[i], conv_qkv_w[i], a_log[i], dt_bias[i],
              dn_norm[i], w_out[i],
              f2_pre[i], f2_post[i], f2_wg[i], f2_wu[i], f2_wd[i],
              ple_pre[i], ple_post[i], w_ple_gate[i], w_ple_proj[i])
        zero_a = jnp.zeros((bp, CONV_A_WIDTH - 1, D_CONV), yp.dtype)
        zero_q = jnp.zeros((bp, DN_CONV_WIDTH - 1, DN_QKV), yp.dtype)
        zero_s = jnp.zeros((bp, DN_HEADS, DN_DK, DN_DV), jnp.float32)
        yp, a1, q1, s1 = layer_forward(yp, p_prompt[i], zero_a, zero_q, zero_s, lw)
        ys, a2, q2, s2 = layer_forward(ys, p_sample[i], state_conv_a[i], state_conv_qkv[i],
                                       state_delta[i], lw)
        ca_p.append(a1); cq_p.append(q1); s_p.append(s1)
        ca_s.append(a2); cq_s.append(q2); s_s.append(s2)
    return (yp, ys, jnp.stack(ca_p), jnp.stack(cq_p), jnp.stack(s_p),
            jnp.stack(ca_s), jnp.stack(cq_s), jnp.stack(s_s))
```

```cpp
#include <hip/hip_runtime.h>
#include <hip/hip_cooperative_groups.h>
#include <cstdio>
namespace cg = cooperative_groups;

#define LAS __attribute__((address_space(3)))
#define DI __device__ __forceinline__
typedef unsigned short bf16_t;
typedef short bf16x8 __attribute__((ext_vector_type(8)));
typedef short s16x4 __attribute__((ext_vector_type(4)));
typedef float f32x2 __attribute__((ext_vector_type(2)));
typedef float f32x4 __attribute__((ext_vector_type(4)));
typedef float f32x16 __attribute__((ext_vector_type(16)));
typedef unsigned u32x2 __attribute__((ext_vector_type(2)));
typedef unsigned u32x4 __attribute__((ext_vector_type(4)));
typedef __bf16 bf16v2 __attribute__((ext_vector_type(2)));

constexpr int MP = 8192, MS = 512, MT = 8704, DM = 2048, FF = 5632, NPROJ = 7168, NINP = 7424, NINR = 7184, DPLE = 256;
constexpr float EPS = 1e-6f;
constexpr size_t O_Y = 0, O_CA_P = 17825792, O_CQ_P = 17833984, O_S_P = 17870848, O_CA_S = 18395136, O_CQ_S = 18657280, O_S_S = 19836928;
constexpr size_t SZ_WGU = 11264ull * 2048 * 2, SZ_WD = 2048ull * 5632 * 2, SZ_WIN = 7424ull * 2048 * 2, SZ_W2K = 2048ull * 2048 * 2, SZ_WPP = 2048ull * 256 * 2;
constexpr size_t OFF_WGU1 = 0, OFF_WD1 = OFF_WGU1 + SZ_WGU, OFF_WIN = OFF_WD1 + SZ_WD, OFF_WOUT = OFF_WIN + SZ_WIN, OFF_WGU2 = OFF_WOUT + SZ_W2K,
                 OFF_WD2 = OFF_WGU2 + SZ_WGU, OFF_WPG = OFF_WD2 + SZ_WD, OFF_WPP = OFF_WPG + SZ_W2K, OFF_H = OFF_WPP + SZ_WPP,
                 OFF_YC = OFF_H + 35651584ull, OFF_PBF = OFF_YC + 35651584ull, OFF_BIG = OFF_PBF + 4456448ull, OFF_Y = OFF_BIG + 124780544ull,
                 OFF_AB = OFF_Y + 75501568ull, OFF_BAR = OFF_AB + 557056ull, OFF_ORAW = OFF_BAR + 16384ull, OFF_RINV = OFF_ORAW + 35651584ull, WS_END = OFF_RINV + 36864ull;
constexpr size_t DITEM = 73728, D_W = 0, D_QG = 16384, D_KDT = 32768, D_QKM = 49152, D_UT = 57344, OFF_GAM = OFF_Y + 1024ull * DITEM;
constexpr int LDS_MAIN = 154624, LDS_BYTES = LDS_MAIN + 16;
#ifndef PROBE_DUP
#define PROBE_DUP 0
#endif
#define DUP(n) for (int _d = 0; _d < ((PROBE_DUP == (n)) ? 2 : 1); ++_d)
#define XDUP(n) for (int _d = 0; _d < ((PROBE_DUP == (n)) ? 1 : 0); ++_d)

struct Params {
    const float *x_prompt, *x_sample, *state_conv_a, *state_conv_qkv, *state_delta, *p_prompt, *p_sample;
    const float *f1_pre, *f1_post, *f1_wg, *f1_wu, *f1_wd;
    const float *mix_pre, *mix_post, *w_in, *conv_a_w, *conv_qkv_w, *a_log, *dt_bias, *dn_norm, *w_out;
    const float *f2_pre, *f2_post, *f2_wg, *f2_wu, *f2_wd;
    const float *ple_pre, *ple_post, *w_ple_gate, *w_ple_proj;
    float* out; unsigned char* ws;
};

DI unsigned pk_bf16(float lo, float hi) { f32x2 f = {lo, hi}; bf16v2 b = __builtin_convertvector(f, bf16v2); return __builtin_bit_cast(unsigned, b); }
DI float bf_lo(unsigned u) { return __uint_as_float(u << 16); }
DI float bf_hi(unsigned u) { return __uint_as_float(u & 0xffff0000u); }
DI float bf2f(bf16_t b) { return __uint_as_float(((unsigned)b) << 16); }
DI float dpp_f(float v, const int ctrl_sel) {
    const int x = __float_as_int(v);
    int r;
    if (ctrl_sel == 0) r = __builtin_amdgcn_update_dpp(x, x, 0xB1, 0xF, 0xF, true);
    else if (ctrl_sel == 1) r = __builtin_amdgcn_update_dpp(x, x, 0x4E, 0xF, 0xF, true);
    else if (ctrl_sel == 2) r = __builtin_amdgcn_update_dpp(x, x, 0x141, 0xF, 0xF, true);
    else r = __builtin_amdgcn_update_dpp(x, x, 0x140, 0xF, 0xF, true);
    return __int_as_float(r);
}
DI float wave_sum(float v) {
    v += dpp_f(v, 0); v += dpp_f(v, 1); v += dpp_f(v, 2); v += dpp_f(v, 3);
    const int x = __float_as_int(v);
    return __int_as_float(__builtin_amdgcn_readlane(x, 0)) + __int_as_float(__builtin_amdgcn_readlane(x, 16)) + __int_as_float(__builtin_amdgcn_readlane(x, 32)) + __int_as_float(__builtin_amdgcn_readlane(x, 48));
}
DI int otid() { int t = threadIdx.x; asm volatile("" : "+v"(t)); return t; }
DI float sigmoidf_(float x) { return __builtin_amdgcn_rcpf(1.0f + __expf(-x)); }
DI float siluf_(float x) { return x * sigmoidf_(x); }

namespace pg8 {
constexpr int BM = 256, BK = 64, HALF = 128, HTB = HALF * BK * 2, STAGE_BYTES = 8 * HTB, NXCD = 8, WGM = 8;
DI int lds_byte(int r, int c) { const int st = (r >> 4) * 2 + (c >> 5), rr = r & 15, cc = c & 31, ob = rr * 64 + cc * 2; return st * 1024 + (ob ^ (((ob >> 9) & 1) << 5)); }
DI void stage_rc(int b, int& R, int& C) { const int st = b / 1024, sb = b % 1024, swz = sb ^ (((sb >> 9) & 1) << 5); R = (st >> 1) * 16 + swz / 64; C = (st & 1) * 32 + (swz % 64) / 2; }
DI int perm32(int rho) { const int n = rho >> 4, i = rho & 15; return 8 * (i >> 2) + 4 * n + (i & 3); }
struct Unit { int pm, pn; };
struct Gemm { const bf16_t* A; const bf16_t* Bt; int M, N, K; };
struct StaticOrder {
    int nM, nN, nwg, G, c;
    DI void init(int M, int N, int G_, int c_) { nM = M / BM; nN = N / BM; nwg = nM * nN; G = G_; c = c_; }
    DI bool next(int i, Unit& u) const {
        const long L = (long)i * G + c; if (L >= nwg) return false;
        int wgid = (int)L; { const int q = nwg / NXCD, r = nwg % NXCD, xcd = wgid % NXCD, off = wgid / NXCD; wgid = (xcd < r ? xcd * (q + 1) : r * (q + 1) + (xcd - r) * q) + off; }
        const int nig = WGM * nN, gid = wgid / nig, fm = gid * WGM, gsz = (nM - fm) < WGM ? (nM - fm) : WGM;
        u.pm = fm + ((wgid % nig) % gsz); u.pn = (wgid % nig) / gsz; return true;
    }
};
struct EpiY {
    static constexpr bool PERM = true;
    bf16_t* C; int ldc;
    DI void operator()(const f32x4 (&acc)[2][2][4][2], const Unit& u, int wr, int wc, int fr, int fq) const {
        const int row0 = u.pm * BM + wr * 64 + fr, col0 = u.pn * BM + wc * 32 + 8 * fq;
#pragma unroll
        for (int ai = 0; ai < 2; ++ai)
#pragma unroll
            for (int m = 0; m < 4; ++m) { bf16_t* rowp = C + (size_t)(row0 + ai * HALF + m * 16) * ldc + col0;
#pragma unroll
                for (int bj = 0; bj < 2; ++bj) { const f32x4 v0 = acc[ai][bj][m][0], v1 = acc[ai][bj][m][1];
                    u32x4 w; w.x = pk_bf16(v0[0], v0[1]); w.y = pk_bf16(v0[2], v0[3]); w.z = pk_bf16(v1[0], v1[1]); w.w = pk_bf16(v1[2], v1[3]);
                    *(u32x4*)(rowp + bj * HALF) = w; } }
    }
};
struct EpiGate {
    static constexpr bool PERM = true;
    bf16_t* C; int ldc;
    DI void operator()(const f32x4 (&acc)[2][2][4][2], const Unit& u, int wr, int wc, int fr, int fq) const {
        const int row0 = u.pm * BM + wr * 64 + fr, col0 = u.pn * BM + wc * 32 + 8 * fq;
#pragma unroll
        for (int ai = 0; ai < 2; ++ai)
#pragma unroll
            for (int m = 0; m < 4; ++m) { bf16_t* rowp = C + (size_t)(row0 + ai * HALF + m * 16) * ldc + col0;
#pragma unroll
                for (int bj = 0; bj < 2; ++bj) { const f32x4 v0 = acc[ai][bj][m][0], v1 = acc[ai][bj][m][1];
                    const u32x4 pp = *(const u32x4*)(rowp + bj * HALF);
                    u32x4 w; w.x = pk_bf16(sigmoidf_(v0[0]) * bf_lo(pp.x), sigmoidf_(v0[1]) * bf_hi(pp.x)); w.y = pk_bf16(sigmoidf_(v0[2]) * bf_lo(pp.y), sigmoidf_(v0[3]) * bf_hi(pp.y));
                    w.z = pk_bf16(sigmoidf_(v1[0]) * bf_lo(pp.z), sigmoidf_(v1[1]) * bf_hi(pp.z)); w.w = pk_bf16(sigmoidf_(v1[2]) * bf_lo(pp.w), sigmoidf_(v1[3]) * bf_hi(pp.w));
                    *(u32x4*)(rowp + bj * HALF) = w; } }
    }
};
struct EpiSwiglu {
    static constexpr bool PERM = true;
    bf16_t* O;
    DI void operator()(const f32x4 (&acc)[2][2][4][2], const Unit& u, int wr, int wc, int fr, int fq) const {
        const int row0 = u.pm * BM + wr * 64 + fr, col0 = u.pn * 128 + wc * 32 + 8 * fq;
#pragma unroll
        for (int ai = 0; ai < 2; ++ai)
#pragma unroll
            for (int m = 0; m < 4; ++m) { bf16_t* rowp = O + (size_t)(row0 + ai * HALF + m * 16) * FF + col0;
                float v[8];
#pragma unroll
                for (int n = 0; n < 2; ++n) { const f32x4 g = acc[ai][0][m][n], uu = acc[ai][1][m][n];
#pragma unroll
                    for (int j = 0; j < 4; j += 2) {
                        const float e0 = 1.0f + __expf(-fmaxf(g[j], -30.f)), e1 = 1.0f + __expf(-fmaxf(g[j + 1], -30.f));
                        const float r = __builtin_amdgcn_rcpf(e0 * e1);
                        v[4 * n + j] = g[j] * uu[j] * (r * e1); v[4 * n + j + 1] = g[j + 1] * uu[j + 1] * (r * e0); } }
                u32x4 w; w.x = pk_bf16(v[0], v[1]); w.y = pk_bf16(v[2], v[3]); w.z = pk_bf16(v[4], v[5]); w.w = pk_bf16(v[6], v[7]);
                *(u32x4*)rowp = w; }
    }
};
struct EpiProj {
    static constexpr bool PERM = true;
    bf16_t* O; float* AB;
    DI void operator()(const f32x4 (&acc)[2][2][4][2], const Unit& u, int wr, int wc, int fr, int fq) const {
        const int row0 = u.pm * BM + wr * 64 + fr;
        if (u.pn < 28) {
            const int col0 = u.pn * BM + wc * 32 + 8 * fq;
#pragma unroll
            for (int ai = 0; ai < 2; ++ai)
#pragma unroll
                for (int m = 0; m < 4; ++m) { bf16_t* rowp = O + (size_t)(row0 + ai * HALF + m * 16) * NPROJ + col0;
#pragma unroll
                    for (int bj = 0; bj < 2; ++bj) { const f32x4 v0 = acc[ai][bj][m][0], v1 = acc[ai][bj][m][1];
                        u32x4 w; w.x = pk_bf16(v0[0], v0[1]); w.y = pk_bf16(v0[2], v0[3]); w.z = pk_bf16(v1[0], v1[1]); w.w = pk_bf16(v1[2], v1[3]);
                        *(u32x4*)(rowp + bj * HALF) = w; } }
        } else if (wc == 0 && fq < 2) {
#pragma unroll
            for (int ai = 0; ai < 2; ++ai)
#pragma unroll
                for (int m = 0; m < 4; ++m) { float* rowp = AB + (size_t)(row0 + ai * HALF + m * 16) * 16 + 8 * fq;
                    *(f32x4*)(rowp) = acc[ai][0][m][0]; *(f32x4*)(rowp + 4) = acc[ai][0][m][1]; }
        }
    }
};

template <class Epi>
DI void gemm_phase(LAS unsigned char* lds, const Gemm g, const StaticOrder& S, const Epi& E) {
    int tid = threadIdx.x; asm volatile("" : "+v"(tid));
    const int wid = __builtin_amdgcn_readfirstlane(tid >> 6), lane = tid & 63, wr = wid >> 2, wc = wid & 3, fr = lane & 15, fq = lane >> 4;
    const int K = g.K, nt = K / BK;
    unsigned voffA[2], voffB[2];
#pragma unroll
    for (int i = 0; i < 2; ++i) { int R, C; stage_rc(tid * 16 + i * 8192, R, C); const int Rb = Epi::PERM ? ((R & ~31) + perm32(R & 31)) : R;
        voffA[i] = (unsigned)(R * K + C) * 2u; voffB[i] = (unsigned)(Rb * K + C) * 2u; }
    const size_t kstep = (size_t)(BK * 2);
    const size_t hstep = (size_t)HALF * K * 2;
    const size_t tstep = 2 * hstep;
    const unsigned ldsw = (unsigned)wid * 1024u;
    const int aoff = lds_byte(wr * 64 + fr, fq * 8), boff = lds_byte(wc * 32 + fr, fq * 8);
#define PG8_SA(b, h) (((b) * 2 + (h)) * HTB)
#define PG8_SB(b, h) ((4 + (b) * 2 + (h)) * HTB)
#define PG8_STAGE(bufoff, gbase, voff) do { _Pragma("unroll") for (int _i = 0; _i < 2; ++_i) \
        __builtin_amdgcn_global_load_lds((const unsigned*)((const char*)(gbase) + (voff)[_i]), (LAS unsigned*)(lds + (bufoff) + ldsw + _i * 8192), 16, 0, 0); } while (0)
#define PG8_LDA(dst, b, h) do { _Pragma("unroll") for (int m = 0; m < 4; ++m) _Pragma("unroll") for (int k = 0; k < 2; ++k) dst[m][k] = *(const LAS bf16x8*)(lds + PG8_SA(b, h) + aoff + m * 2048 + k * 1024); } while (0)
#define PG8_LDB(dst, b, h) do { _Pragma("unroll") for (int n = 0; n < 2; ++n) _Pragma("unroll") for (int k = 0; k < 2; ++k) dst[n][k] = *(const LAS bf16x8*)(lds + PG8_SB(b, h) + boff + n * 2048 + k * 1024); } while (0)
#define PG8_MMA(ai, bj, At, Bt) do { __builtin_amdgcn_s_setprio(1); _Pragma("unroll") for (int m = 0; m < 4; ++m) _Pragma("unroll") for (int n = 0; n < 2; ++n) _Pragma("unroll") for (int k = 0; k < 2; ++k) \
        acc[ai][bj][m][n] = __builtin_amdgcn_mfma_f32_16x16x32_bf16(Bt[n][k], At[m][k], acc[ai][bj][m][n], 0, 0, 0); __builtin_amdgcn_s_setprio(0); } while (0)
#define PG8_WAIT_V(n) asm volatile("s_waitcnt vmcnt(" #n ")" ::: "memory")
#define PG8_WAIT_L(n) asm volatile("s_waitcnt lgkmcnt(" #n ")" ::: "memory")
#define PG8_BAR __builtin_amdgcn_s_barrier()
#define PG8_SCHED __builtin_amdgcn_sched_barrier(0)
    Unit cur, nxt; int ui = 0;
    if (!S.next(0, cur)) return;
    f32x4 acc[2][2][4][2];
#pragma unroll
    for (int a = 0; a < 2; ++a)
#pragma unroll
        for (int b = 0; b < 2; ++b)
#pragma unroll
            for (int m = 0; m < 4; ++m)
#pragma unroll
                for (int n = 0; n < 2; ++n) acc[a][b][m][n] = (f32x4){0.f, 0.f, 0.f, 0.f};
    bf16x8 At[4][2], B0[2][2], B1[2][2];
    const char* cA = (const char*)g.A + (size_t)cur.pm * tstep; const char* cB = (const char*)g.Bt + (size_t)cur.pn * tstep;
    PG8_STAGE(PG8_SB(0, 0), cB, voffB); PG8_STAGE(PG8_SA(0, 0), cA, voffA); PG8_STAGE(PG8_SB(0, 1), cB + hstep, voffB); PG8_STAGE(PG8_SA(0, 1), cA + hstep, voffA);
    if (wr == 1) PG8_BAR;
    PG8_WAIT_V(4); PG8_BAR;
    PG8_STAGE(PG8_SB(1, 0), cB + kstep, voffB); PG8_STAGE(PG8_SA(1, 0), cA + kstep, voffA); PG8_STAGE(PG8_SB(1, 1), cB + hstep + kstep, voffB);
    PG8_WAIT_V(6); PG8_BAR;
    for (;;) {
        const bool has_next = S.next(ui + 1, nxt);
        const char* nA = has_next ? (const char*)g.A + (size_t)nxt.pm * tstep : cA; const char* nB = has_next ? (const char*)g.Bt + (size_t)nxt.pn * tstep : cB;
        for (int t = 0; t < nt; t += 2) {
            const bool last = (t == nt - 2);
            const char* a1 = cA + (size_t)(t + 1) * kstep;
            const char* a2 = last ? nA : cA + (size_t)(t + 2) * kstep; const char* b2 = last ? nB : cB + (size_t)(t + 2) * kstep;
            const char* a3 = a2 + kstep; const char* b3 = b2 + kstep;
            PG8_LDB(B0, 0, 0); PG8_SCHED; PG8_LDA(At, 0, 0); PG8_STAGE(PG8_SA(1, 1), a1 + hstep, voffA);
            PG8_WAIT_L(8); PG8_BAR; PG8_WAIT_L(0); PG8_MMA(0, 0, At, B0); PG8_BAR; PG8_SCHED;
            PG8_LDB(B1, 0, 1); PG8_STAGE(PG8_SB(0, 0), b2, voffB);
            PG8_BAR; PG8_WAIT_L(0); PG8_MMA(0, 1, At, B1); PG8_BAR;
            PG8_LDA(At, 0, 1); PG8_STAGE(PG8_SA(0, 0), a2, voffA);
            PG8_BAR; PG8_WAIT_L(0); PG8_MMA(1, 0, At, B0); PG8_BAR; PG8_SCHED;
            PG8_STAGE(PG8_SB(0, 1), b2 + hstep, voffB);
            PG8_WAIT_V(6); PG8_BAR; PG8_MMA(1, 1, At, B1); PG8_BAR;
            PG8_LDB(B0, 1, 0); PG8_SCHED; PG8_LDA(At, 1, 0); PG8_STAGE(PG8_SA(0, 1), a2 + hstep, voffA);
            PG8_WAIT_L(8); PG8_BAR; PG8_WAIT_L(0); PG8_MMA(0, 0, At, B0); PG8_BAR; PG8_SCHED;
            PG8_LDB(B1, 1, 1); PG8_STAGE(PG8_SB(1, 0), b3, voffB);
            PG8_BAR; PG8_WAIT_L(0); PG8_MMA(0, 1, At, B1); PG8_BAR;
            PG8_LDA(At, 1, 1); PG8_STAGE(PG8_SA(1, 0), a3, voffA);
            PG8_BAR; PG8_WAIT_L(0); PG8_MMA(1, 0, At, B0); PG8_BAR; PG8_SCHED;
            PG8_STAGE(PG8_SB(1, 1), b3 + hstep, voffB);
            PG8_WAIT_V(6); PG8_BAR; PG8_MMA(1, 1, At, B1); PG8_BAR;
        }
        E(acc, cur, wr, wc, fr, fq);
        if (!has_next) break;
#pragma unroll
        for (int a = 0; a < 2; ++a)
#pragma unroll
            for (int b = 0; b < 2; ++b)
#pragma unroll
                for (int m = 0; m < 4; ++m)
#pragma unroll
                    for (int n = 0; n < 2; ++n) acc[a][b][m][n] = (f32x4){0.f, 0.f, 0.f, 0.f};
        cur = nxt; cA = nA; cB = nB; ++ui;
    }
    PG8_WAIT_V(0);
    if (wr == 0) PG8_BAR;
    PG8_BAR;
#undef PG8_SA
#undef PG8_SB
#undef PG8_STAGE
#undef PG8_LDA
#undef PG8_LDB
#undef PG8_MMA
#undef PG8_WAIT_V
#undef PG8_WAIT_L
#undef PG8_BAR
#undef PG8_SCHED
}
}

template <class Epi>
DI void run_gemm(LAS unsigned char* lds, const bf16_t* A, const bf16_t* Bt, int M, int N, int K, const Epi& E) {
    pg8::Gemm g{A, Bt, M, N, K}; pg8::StaticOrder S; S.init(M, N, (int)gridDim.x, (int)blockIdx.x);
    pg8::gemm_phase<Epi>(lds, g, S, E);
}

template <int MODE>
DI void small_gemm(unsigned char* lds, const bf16_t* __restrict__ A, const bf16_t* __restrict__ Bt, int K, bf16_t* Yrows) {
    const int tid = otid(), wid = tid >> 6, lane = tid & 63, fr = lane & 15, fq = lane >> 4;
    const int wm = wid >> 1, wn = wid & 1, nk = K >> 7;
    const int lr = tid >> 4, lc = tid & 15;
    constexpr int RS = 272, BUF = 64 * RS;
    for (int tile = blockIdx.x; tile < 256; tile += gridDim.x) {
        const int ms = tile >> 5, ns = tile & 31;
        const bf16_t* ap = A + (size_t)(ms * 64 + lr) * K + lc * 8;
        const bf16_t* bp = Bt + (size_t)(ns * 64 + lr) * K + lc * 8;
        const size_t r32 = (size_t)32 * K;
        u32x4 ra[4][2], rb[4][2];
#define SG_LOAD(j, t) do { if ((t) < nk) { ra[j][0] = *(const u32x4*)(ap + (t) * 128); ra[j][1] = *(const u32x4*)(ap + r32 + (t) * 128); rb[j][0] = *(const u32x4*)(bp + (t) * 128); rb[j][1] = *(const u32x4*)(bp + r32 + (t) * 128); } } while (0)
#define SG_WRITE(j, t) do { if ((t) < nk) { unsigned char* d = lds + ((t) & 1) * (2 * BUF) + lr * RS + lc * 16; \
        *(u32x4*)d = ra[j][0]; *(u32x4*)(d + 32 * RS) = ra[j][1]; *(u32x4*)(d + BUF) = rb[j][0]; *(u32x4*)(d + BUF + 32 * RS) = rb[j][1]; } } while (0)
#define SG_COMPUTE(t) do { const unsigned char* bA = lds + ((t) & 1) * (2 * BUF) + (16 * wm + fr) * RS + fq * 16; const unsigned char* bB = lds + ((t) & 1) * (2 * BUF) + BUF + (32 * wn + fr) * RS + fq * 16; \
        _Pragma("unroll") for (int kk = 0; kk < 4; ++kk) { const bf16x8 fa = *(const bf16x8*)(bA + kk * 64), f0 = *(const bf16x8*)(bB + kk * 64), f1 = *(const bf16x8*)(bB + 16 * RS + kk * 64); \
            acc0 = __builtin_amdgcn_mfma_f32_16x16x32_bf16(f0, fa, acc0, 0, 0, 0); acc1 = __builtin_amdgcn_mfma_f32_16x16x32_bf16(f1, fa, acc1, 0, 0, 0); } } while (0)
#define SG_STEP(j, t) do { if ((t) < nk) { __syncthreads(); SG_COMPUTE(t); SG_WRITE(((j) + 1) & 3, (t) + 1); SG_LOAD(j, (t) + 4); } } while (0)
        f32x4 acc0 = {0.f, 0.f, 0.f, 0.f}, acc1 = {0.f, 0.f, 0.f, 0.f};
        SG_LOAD(0, 0); SG_LOAD(1, 1); SG_LOAD(2, 2); SG_LOAD(3, 3);
        SG_WRITE(0, 0);
        for (int t = 0; t < nk; t += 4) { SG_STEP(0, t); SG_STEP(1, t + 1); SG_STEP(2, t + 2); SG_STEP(3, t + 3); }
#undef SG_LOAD
#undef SG_WRITE
#undef SG_COMPUTE
#undef SG_STEP
        bf16_t* yp = Yrows + (size_t)(ms * 64 + 16 * wm + fr) * DM + ns * 64 + 32 * wn + 4 * fq;
        if (MODE == 1) {
            const u32x2 p0 = *(const u32x2*)yp, p1 = *(const u32x2*)(yp + 16);
            acc0[0] = sigmoidf_(acc0[0]) * bf_lo(p0.x); acc0[1] = sigmoidf_(acc0[1]) * bf_hi(p0.x); acc0[2] = sigmoidf_(acc0[2]) * bf_lo(p0.y); acc0[3] = sigmoidf_(acc0[3]) * bf_hi(p0.y);
            acc1[0] = sigmoidf_(acc1[0]) * bf_lo(p1.x); acc1[1] = sigmoidf_(acc1[1]) * bf_hi(p1.x); acc1[2] = sigmoidf_(acc1[2]) * bf_lo(p1.y); acc1[3] = sigmoidf_(acc1[3]) * bf_hi(p1.y);
        }
        u32x2 w0, w1; w0.x = pk_bf16(acc0[0], acc0[1]); w0.y = pk_bf16(acc0[2], acc0[3]); w1.x = pk_bf16(acc1[0], acc1[1]); w1.y = pk_bf16(acc1[2], acc1[3]);
        *(u32x2*)yp = w0; *(u32x2*)(yp + 16) = w1;
        __syncthreads();
    }
}

DI int rowmap(int n, int mode) { return mode == 0 ? n : ((n >> 7) * 256 + (mode == 2 ? 128 : 0) + (n & 127)); }
struct ConvTile { const float* src; bf16_t* dst; const float* gain; int K, N, mode, k0, n0; bool valid; };
DI ConvTile conv_decode(const Params& p, int g) {
    ConvTile c; c.valid = false; c.src = nullptr; c.dst = nullptr; c.gain = nullptr; c.K = 0; c.N = 0; c.mode = 0; c.k0 = 0; c.n0 = 0;
    int base = 0;
#define CJOB(S, D, G, KK, NN, MM) { const int nTn = ((NN) + 255) >> 8, nt = ((KK) >> 6) * nTn; if (g >= base && g < base + nt) { const int t = g - base, tk = t / nTn; \
        c.src = (S); c.dst = (bf16_t*)(p.ws + (D)); c.gain = (G); c.K = (KK); c.N = (NN); c.mode = (MM); c.k0 = tk * 64; c.n0 = (t - tk * nTn) * 256; c.valid = true; } base += nt; }
    CJOB(p.f1_wg, OFF_WGU1, p.f1_pre, 2048, 5632, 1)
    CJOB(p.f1_wu, OFF_WGU1, p.f1_pre, 2048, 5632, 2)
    CJOB(p.w_in, OFF_WIN, p.mix_pre, 2048, NINR, 0)
    CJOB(p.f1_wd, OFF_WD1, nullptr, 5632, 2048, 0)
    CJOB(p.w_out, OFF_WOUT, nullptr, 2048, 2048, 0)
    CJOB(p.w_ple_gate, OFF_WPG, p.ple_pre, 2048, 2048, 0)
    CJOB(p.w_ple_proj, OFF_WPP, nullptr, 256, 2048, 0)
    CJOB(p.f2_wg, OFF_WGU2, p.f2_pre, 2048, 5632, 1)
    CJOB(p.f2_wu, OFF_WGU2, p.f2_pre, 2048, 5632, 2)
    CJOB(p.f2_wd, OFF_WD2, nullptr, 5632, 2048, 0)
#undef CJOB
    return c;
}
constexpr int CT_P0 = 2 * 704 + 928, CT_WD1 = CT_P0 + 704, CT_MISC = CT_WD1 + 256 + 256 + 32, CT_SHADOW = CT_MISC + 2 * 704, CONV_TILES = CT_SHADOW + 704;
DI void conv_load(const ConvTile& c, int tid, f32x4 (&r)[8]) {
    const int n4 = (tid & 63) * 4, kr = (tid >> 6) * 2;
#pragma unroll
    for (int ps = 0; ps < 4; ++ps) {
        const int kk = ps * 16 + kr;
        f32x4 a = {0.f, 0.f, 0.f, 0.f}, b = {0.f, 0.f, 0.f, 0.f};
        if (c.valid && c.n0 + n4 < c.N) { a = __builtin_nontemporal_load((const f32x4*)(c.src + (size_t)(c.k0 + kk) * c.N + c.n0 + n4)); b = __builtin_nontemporal_load((const f32x4*)(c.src + (size_t)(c.k0 + kk + 1) * c.N + c.n0 + n4)); }
        r[2 * ps] = a; r[2 * ps + 1] = b;
    }
}
DI void conv_store(const ConvTile& c, int tid, const f32x4 (&r)[8], unsigned* lds) {
    const int n4 = (tid & 63) * 4, kr = (tid >> 6) * 2;
#pragma unroll
    for (int ps = 0; ps < 4; ++ps) {
        const int kk = ps * 16 + kr;
        f32x4 a = r[2 * ps], b = r[2 * ps + 1];
        if (c.gain) { const float g0 = c.gain[c.k0 + kk], g1 = c.gain[c.k0 + kk + 1]; a *= g0; b *= g1; }
#pragma unroll
        for (int i = 0; i < 4; ++i) lds[(n4 + i) * 33 + (kk >> 1)] = pk_bf16(a[i], b[i]);
    }
    __syncthreads();
#pragma unroll
    for (int q2 = 0; q2 < 4; ++q2) {
        const int q = tid + q2 * 512, n = q >> 3, kc = q & 7;
        u32x4 w; w.x = lds[n * 33 + kc * 4 + 0]; w.y = lds[n * 33 + kc * 4 + 1]; w.z = lds[n * 33 + kc * 4 + 2]; w.w = lds[n * 33 + kc * 4 + 3];
        const int nn = c.n0 + n;
        if (c.mode == 0 || nn < c.N) *(u32x4*)(c.dst + (size_t)rowmap(nn, c.mode) * c.K + c.k0 + kc * 8) = w;
    }
    __syncthreads();
}
DI void conv_phase(const Params& p, unsigned* lds, int t_begin, int t_end, int rank, int nranks) {
    const int tid = otid(), G = nranks;
    int g = t_begin + rank;
    if (g >= t_end) return;
    ConvTile c0 = conv_decode(p, g), c1;
    f32x4 r0[8], r1[8];
    conv_load(c0, tid, r0);
    for (;;) {
        c1 = conv_decode(p, g + G); if (g + G >= t_end) c1.valid = false;
        conv_load(c1, tid, r1);
        conv_store(c0, tid, r0, lds);
        if (!c1.valid) break;
        c0 = conv_decode(p, g + 2 * G); if (g + 2 * G >= t_end) c0.valid = false;
        conv_load(c0, tid, r0);
        conv_store(c1, tid, r1, lds);
        if (!c0.valid) break;
        g += 2 * G;
    }
}

DI void tail_conv(const Params& p, unsigned* lds, int nwg, int t_begin, int t_end) {
    const int G = gridDim.x, rounds = (nwg + G - 1) / G; int idle0 = nwg - (rounds - 1) * G; if (idle0 >= G) idle0 = 0;
    if ((int)blockIdx.x >= idle0) conv_phase(p, lds, t_begin, t_end, (int)blockIdx.x - idle0, G - idle0);
}

DI void row_phase(const Params& p, int which, bool dummy = false) {
    const int tid = otid(), lane = tid & 63, gw = blockIdx.x * 8 + (tid >> 6), nw = gridDim.x * 8;
    const bf16_t* Y = (const bf16_t*)(p.ws + OFF_Y); const bf16_t* H = (const bf16_t*)(p.ws + OFF_H); const float* RINV = (const float*)(p.ws + OFF_RINV);
    bf16_t* Hd = (bf16_t*)(p.ws + (dummy ? OFF_YC : OFF_H)); float* RINVd = (float*)(p.ws + (dummy ? OFF_AB : OFF_RINV));
    const float* gpost = which == 1 ? p.f1_post : which == 2 ? p.mix_post : which == 3 ? p.f2_post : p.ple_post;
    const float scale = (which == 1 || which == 3) ? 0.5f : 1.0f;
    for (int row = gw; row < MT; row += nw) {
        f32x4 x[8];
        if (which <= 1) {
            const float* xs = row < MP ? p.x_prompt + (size_t)row * DM : p.x_sample + (size_t)(row - MP) * DM;
#pragma unroll
            for (int it = 0; it < 8; ++it) x[it] = *(const f32x4*)(xs + (it * 64 + lane) * 4);
        } else {
            const float ri = RINV[row];
#pragma unroll
            for (int it = 0; it < 8; ++it) { const u32x2 hh = *(const u32x2*)(H + (size_t)row * DM + (it * 64 + lane) * 4);
                x[it] = (f32x4){bf_lo(hh.x) * ri, bf_hi(hh.x) * ri, bf_lo(hh.y) * ri, bf_hi(hh.y) * ri}; }
        }
        if (which > 0) {
            f32x4 y[8]; float ss = 0.f;
#pragma unroll
            for (int it = 0; it < 8; ++it) { const u32x2 yy = __builtin_nontemporal_load((const u32x2*)(Y + (size_t)row * DM + (it * 64 + lane) * 4));
                y[it] = (f32x4){bf_lo(yy.x), bf_hi(yy.x), bf_lo(yy.y), bf_hi(yy.y)}; ss += y[it][0] * y[it][0] + y[it][1] * y[it][1] + y[it][2] * y[it][2] + y[it][3] * y[it][3]; }
            ss = wave_sum(ss);
            const float r = rsqrtf(ss * (1.0f / DM) + EPS) * scale;
#pragma unroll
            for (int it = 0; it < 8; ++it) { const f32x4 gp = *(const f32x4*)(gpost + (it * 64 + lane) * 4);
#pragma unroll
                for (int j = 0; j < 4; ++j) x[it][j] += y[it][j] * r * gp[j]; }
        }
        if (which == 4) {
#pragma unroll
            for (int it = 0; it < 8; ++it) __builtin_nontemporal_store(x[it], (f32x4*)(p.out + (size_t)row * DM + (it * 64 + lane) * 4));
        } else {
            float ss = 0.f;
#pragma unroll
            for (int it = 0; it < 8; ++it) ss += x[it][0] * x[it][0] + x[it][1] * x[it][1] + x[it][2] * x[it][2] + x[it][3] * x[it][3];
            ss = wave_sum(ss);
            const float ms = ss * (1.0f / DM) + EPS, r = rsqrtf(ms);
            if (lane == 0) RINVd[row] = ms * r;
#pragma unroll
            for (int it = 0; it < 8; ++it) { u32x2 w; w.x = pk_bf16(x[it][0] * r, x[it][1] * r); w.y = pk_bf16(x[it][2] * r, x[it][3] * r);
                *(u32x2*)(Hd + (size_t)row * DM + (it * 64 + lane) * 4) = w; }
        }
    }
}

DI void mixer_a_phase(const Params& p) {
    const bf16_t* PJ = (const bf16_t*)(p.ws + OFF_BIG); bf16_t* YC = (bf16_t*)(p.ws + OFF_YC);
    const int gt = ((int)blockIdx.x - 32) * 512 + otid(), nthr = ((int)gridDim.x - 32) * 512;
    for (int it = gt; it < MT * 128; it += nthr) {
        const int row = it >> 7, c = (it & 127) * 8;
        int tt, T, s = 0, b = 0;
        if (row < MP) { tt = row & 2047; T = 2048; b = row >> 11; } else { s = (row - MP) >> 2; tt = (row - MP) & 3; T = 4; }
        float u[3][8];
#pragma unroll
        for (int j = 0; j < 3; ++j) {
            const int tp = tt - 2 + j;
            if (tp >= 0) {
                const bf16_t* rp = PJ + (size_t)(row - 2 + j) * NPROJ;
                const u32x4 a = *(const u32x4*)(rp + 1024 + c), h = *(const u32x4*)(rp + 2048 + c);
#pragma unroll
                for (int e = 0; e < 4; ++e) { u[j][2 * e] = bf_lo(a[e]) * bf_lo(h[e]); u[j][2 * e + 1] = bf_hi(a[e]) * bf_hi(h[e]); }
            } else if (row >= MP) {
                const float* sp = p.state_conv_a + ((size_t)s * 2 + (2 + tp)) * 1024 + c;
                const f32x4 a = *(const f32x4*)sp, bq = *(const f32x4*)(sp + 4);
#pragma unroll
                for (int e = 0; e < 4; ++e) { u[j][e] = a[e]; u[j][4 + e] = bq[e]; }
            } else {
#pragma unroll
                for (int e = 0; e < 8; ++e) u[j][e] = 0.f;
            }
        }
        const u32x4 gb = *(const u32x4*)(PJ + (size_t)row * NPROJ + c);
        float y[8];
#pragma unroll
        for (int e = 0; e < 8; ++e) {
            const float w0 = p.conv_a_w[c + e], w1 = p.conv_a_w[1024 + c + e], w2 = p.conv_a_w[2048 + c + e];
            const float g = (e & 1) ? bf_hi(gb[e >> 1]) : bf_lo(gb[e >> 1]);
            y[e] = g * (w0 * u[0][e] + w1 * u[1][e] + w2 * u[2][e]);
        }
        u32x4 w; w.x = pk_bf16(y[0], y[1]); w.y = pk_bf16(y[2], y[3]); w.z = pk_bf16(y[4], y[5]); w.w = pk_bf16(y[6], y[7]);
        *(u32x4*)(YC + (size_t)row * DM + c) = w;
        if (tt >= T - 2) {
            float* op = (row < MP) ? p.out + O_CA_P + ((size_t)b * 2 + (tt - (T - 2))) * 1024 + c : p.out + O_CA_S + ((size_t)s * 2 + (tt - 2)) * 1024 + c;
            *(f32x4*)op = (f32x4){u[2][0], u[2][1], u[2][2], u[2][3]}; *(f32x4*)(op + 4) = (f32x4){u[2][4], u[2][5], u[2][6], u[2][7]};
        }
    }
    for (int it = gt; it < (4 + 128) * 3 * 384; it += nthr) {
        const int c = (it % 384) * 8, rj = it / 384, seq = rj / 3, j = rj % 3;
        const int row = seq < 4 ? seq * 2048 + 2045 + j : MP + (seq - 4) * 4 + 1 + j;
        float* op = seq < 4 ? p.out + O_CQ_P + ((size_t)seq * 3 + j) * 3072 + c : p.out + O_CQ_S + ((size_t)(seq - 4) * 3 + j) * 3072 + c;
        const u32x4 a = *(const u32x4*)(PJ + (size_t)row * NPROJ + 3072 + c);
        *(f32x4*)op = (f32x4){bf_lo(a[0]), bf_hi(a[0]), bf_lo(a[1]), bf_hi(a[1])}; *(f32x4*)(op + 4) = (f32x4){bf_lo(a[2]), bf_hi(a[2]), bf_lo(a[3]), bf_hi(a[3])};
    }
}

DI float softplusf_(float x) { return x > 20.f ? x : log1pf(__expf(x)); }

constexpr int PL_QS = 0, PL_KS = 17408, PL_KT = 34816, PL_VT = 53248, PL_AS = 71680, PL_TF = 88064, PL_TC = 97280, PL_XT = 99840, PL_T1 = 102400, PL_T2 = 111616, PL_SM = 120832;
DI bf16_t f2bf(float x) { return (bf16_t)(pk_bf16(x, 0.f) & 0xffffu); }
DI void prep_phase(const Params& p, unsigned char* lds) {
    int tid = threadIdx.x; asm volatile("" : "+v"(tid));
    const int wid = tid >> 6, lane = tid & 63, fr = lane & 15, fq = lane >> 4;
    bf16_t* qs = (bf16_t*)(lds + PL_QS); bf16_t* ks = (bf16_t*)(lds + PL_KS); bf16_t* kT = (bf16_t*)(lds + PL_KT); bf16_t* vT = (bf16_t*)(lds + PL_VT);
    float* As = (float*)(lds + PL_AS); bf16_t* TF = (bf16_t*)(lds + PL_TF); bf16_t* TC = (bf16_t*)(lds + PL_TC); bf16_t* XT = (bf16_t*)(lds + PL_XT);
    bf16_t* T1 = (bf16_t*)(lds + PL_T1); bf16_t* T2 = (bf16_t*)(lds + PL_T2); float* sm = (float*)(lds + PL_SM);
    const bf16_t* PJ = (const bf16_t*)(p.ws + OFF_BIG); const float* AB = (const float*)(p.ws + OFF_AB);
    for (int item0 = blockIdx.x; item0 < 1024 * (PROBE_DUP == 6 ? 2 : 1); item0 += gridDim.x) {
        const int item = item0 & 1023, bh = item >> 5, n = item & 31, b = bh >> 3, h = bh & 7, t0 = n * 64;
        unsigned char* DI_ = p.ws + OFF_Y + (size_t)item * DITEM;
        {
            const int tl0 = wid * 8, cb = h * 128 + 2 * lane;
            float wq[4][2], wk[4][2], wv[4][2];
#pragma unroll
            for (int j = 0; j < 4; ++j) { const f32x2 a = *(const f32x2*)(p.conv_qkv_w + j * 3072 + cb), bq = *(const f32x2*)(p.conv_qkv_w + j * 3072 + 1024 + cb), c = *(const f32x2*)(p.conv_qkv_w + j * 3072 + 2048 + cb);
                wq[j][0] = a.x; wq[j][1] = a.y; wk[j][0] = bq.x; wk[j][1] = bq.y; wv[j][0] = c.x; wv[j][1] = c.y; }
            const float Aexp = __expf(p.a_log[h]), dtb = p.dt_bias[h];
            unsigned xr[11][3];
#pragma unroll
            for (int i = 0; i < 11; ++i) {
                const int tt = t0 + tl0 - 3 + i; const int ttc = tt < 0 ? 0 : tt; const unsigned msk = tt < 0 ? 0u : 0xffffffffu;
                const bf16_t* rp = PJ + (size_t)(b * 2048 + ttc) * NPROJ + 3072 + cb;
                xr[i][0] = *(const unsigned*)rp & msk; xr[i][1] = *(const unsigned*)(rp + 1024) & msk; xr[i][2] = *(const unsigned*)(rp + 2048) & msk;
            }
            if (lane < 8) {
                const size_t row = (size_t)b * 2048 + t0 + tl0 + lane;
                const float a = AB[row * 16 + h], bb = AB[row * 16 + 8 + h];
                sm[tl0 + lane] = -Aexp * softplusf_(a + dtb); sm[64 + tl0 + lane] = sigmoidf_(bb);
            }
#pragma unroll
            for (int i = 0; i < 8; ++i) {
                float q0 = 0.f, q1 = 0.f, k0 = 0.f, k1 = 0.f, v0 = 0.f, v1 = 0.f;
#pragma unroll
                for (int j = 0; j < 4; ++j) {
                    q0 += wq[j][0] * bf_lo(xr[i + j][0]); q1 += wq[j][1] * bf_hi(xr[i + j][0]);
                    k0 += wk[j][0] * bf_lo(xr[i + j][1]); k1 += wk[j][1] * bf_hi(xr[i + j][1]);
                    v0 += wv[j][0] * bf_lo(xr[i + j][2]); v1 += wv[j][1] * bf_hi(xr[i + j][2]);
                }
                q0 = siluf_(q0); q1 = siluf_(q1); k0 = siluf_(k0); k1 = siluf_(k1); v0 = siluf_(v0); v1 = siluf_(v1);
                const float sq = wave_sum(q0 * q0 + q1 * q1), sk = wave_sum(k0 * k0 + k1 * k1);
                const float rq = rsqrtf(sq + EPS) * 0.08838834764831845f, rk = rsqrtf(sk + EPS);
                const int tl = tl0 + i;
                const unsigned kk = pk_bf16(k0 * rk, k1 * rk), vv = pk_bf16(v0, v1);
                *(unsigned*)(qs + tl * 136 + 2 * lane) = pk_bf16(q0 * rq, q1 * rq);
                *(unsigned*)(ks + tl * 136 + 2 * lane) = kk;
                kT[(2 * lane) * 72 + tl] = (bf16_t)(kk & 0xffffu); kT[(2 * lane + 1) * 72 + tl] = (bf16_t)(kk >> 16);
                vT[(2 * lane) * 72 + tl] = (bf16_t)(vv & 0xffffu); vT[(2 * lane + 1) * 72 + tl] = (bf16_t)(vv >> 16);
            }
        }
        __syncthreads();
        if (tid < 64) {
            float acc = 0.f, mine = 0.f;
            for (int j = 0; j < 64; ++j) { acc += sm[j]; if (j == tid) mine = acc; }
            sm[128 + tid] = mine; sm[192 + tid] = sm[64 + tid] * __expf(mine); sm[256 + tid] = __expf(mine); sm[320 + tid] = __expf(acc - mine);
            if (tid == 63) ((float*)(p.ws + OFF_GAM))[item] = __expf(acc);
        }
        __syncthreads();
        {
            const int ib = wid >> 1;
            bf16_t* QKM = (bf16_t*)(DI_ + D_QKM);
#pragma unroll
            for (int jj2 = 0; jj2 < 2; ++jj2) {
                const int jb = 2 * (wid & 1) + jj2;
                if (jb <= ib) {
                    f32x4 aK = {0.f, 0.f, 0.f, 0.f}, aQ = {0.f, 0.f, 0.f, 0.f};
#pragma unroll
                    for (int kk = 0; kk < 4; ++kk) {
                        const bf16x8 fa_k = *(const bf16x8*)(ks + (ib * 16 + fr) * 136 + kk * 32 + fq * 8);
                        const bf16x8 fa_q = *(const bf16x8*)(qs + (ib * 16 + fr) * 136 + kk * 32 + fq * 8);
                        const bf16x8 fb = *(const bf16x8*)(ks + (jb * 16 + fr) * 136 + kk * 32 + fq * 8);
                        aK = __builtin_amdgcn_mfma_f32_16x16x32_bf16(fa_k, fb, aK, 0, 0, 0);
                        aQ = __builtin_amdgcn_mfma_f32_16x16x32_bf16(fa_q, fb, aQ, 0, 0, 0);
                    }
#pragma unroll
                    for (int jj = 0; jj < 4; ++jj) {
                        const int i = ib * 16 + fq * 4 + jj, j = jb * 16 + fr;
                        const float dec = (i >= j) ? __expf(sm[128 + i] - sm[128 + j]) : 0.f;
                        As[i * 64 + j] = (i > j) ? sm[64 + i] * aK[jj] * dec : 0.f;
                        QKM[i * 64 + j] = f2bf(aQ[jj] * dec);
                    }
                } else {
#pragma unroll
                    for (int jj = 0; jj < 4; ++jj) QKM[(ib * 16 + fq * 4 + jj) * 64 + jb * 16 + fr] = 0;
                }
            }
            {
                const int i = tid >> 3, d0 = (tid & 7) * 16; const float e = sm[256 + i];
                bf16_t* QG = (bf16_t*)(DI_ + D_QG);
#pragma unroll
                for (int hhalf = 0; hhalf < 2; ++hhalf) {
                    const u32x4 v = *(const u32x4*)(qs + i * 136 + d0 + 8 * hhalf);
                    u32x4 w; w.x = pk_bf16(bf_lo(v.x) * e, bf_hi(v.x) * e); w.y = pk_bf16(bf_lo(v.y) * e, bf_hi(v.y) * e); w.z = pk_bf16(bf_lo(v.z) * e, bf_hi(v.z) * e); w.w = pk_bf16(bf_lo(v.w) * e, bf_hi(v.w) * e);
                    *(u32x4*)(QG + i * 128 + d0 + 8 * hhalf) = w;
                }
            }
            {
                const int d = tid >> 2, j0 = (tid & 3) * 16;
                bf16_t* KDT = (bf16_t*)(DI_ + D_KDT);
#pragma unroll
                for (int hhalf = 0; hhalf < 2; ++hhalf) {
                    const int jj0 = j0 + 8 * hhalf;
                    const u32x4 v = *(const u32x4*)(kT + d * 72 + jj0);
                    const f32x4 e0 = *(const f32x4*)(sm + 320 + jj0), e1 = *(const f32x4*)(sm + 320 + jj0 + 4);
                    u32x4 w; w.x = pk_bf16(bf_lo(v.x) * e0[0], bf_hi(v.x) * e0[1]); w.y = pk_bf16(bf_lo(v.y) * e0[2], bf_hi(v.y) * e0[3]); w.z = pk_bf16(bf_lo(v.z) * e1[0], bf_hi(v.z) * e1[1]); w.w = pk_bf16(bf_lo(v.w) * e1[2], bf_hi(v.w) * e1[3]);
                    *(u32x4*)(KDT + d * 64 + jj0) = w;
                }
            }
        }
        __syncthreads();
        if (wid == 0) {
            const int c = lane & 31, hb = lane >> 5;
            const float* Ab = As + (32 * hb) * 64 + 32 * hb;
            float t[32];
#pragma unroll
            for (int i = 0; i < 32; ++i) t[i] = 0.f;
#pragma unroll
            for (int il = 0; il < 32; ++il) {
                float a = (il == c) ? 1.f : 0.f;
#pragma unroll
                for (int j4 = 0; j4 < (il + 3) / 4; ++j4) {
                    const f32x4 av = *(const f32x4*)(Ab + il * 64 + j4 * 4);
#pragma unroll
                    for (int e = 0; e < 4; ++e) if (4 * j4 + e < il) a = __builtin_fmaf(-av[e], t[4 * j4 + e], a);
                }
                asm volatile("" : "+v"(a) :: "memory");
                t[il] = a;
            }
#pragma unroll
            for (int il = 0; il < 32; ++il) { TF[(32 * hb + il) * 72 + 32 * hb + c] = f2bf(t[il]); if (hb == 0) TF[il * 72 + 32 + c] = 0; }
            if (hb == 0) {
#pragma unroll
                for (int i8 = 0; i8 < 4; ++i8) { u32x4 w; w.x = pk_bf16(t[8 * i8], t[8 * i8 + 1]); w.y = pk_bf16(t[8 * i8 + 2], t[8 * i8 + 3]); w.z = pk_bf16(t[8 * i8 + 4], t[8 * i8 + 5]); w.w = pk_bf16(t[8 * i8 + 6], t[8 * i8 + 7]);
                    *(u32x4*)(TC + c * 40 + 8 * i8) = w; }
            }
        }
        __syncthreads();
        if (wid < 4) {
            const int tr = wid >> 1, tc = wid & 1;
            const float* ap = As + (32 + 16 * tr + fr) * 64 + fq * 8;
            const f32x4 a0 = *(const f32x4*)ap, a1 = *(const f32x4*)(ap + 4);
            u32x4 pa; pa.x = pk_bf16(a0[0], a0[1]); pa.y = pk_bf16(a0[2], a0[3]); pa.z = pk_bf16(a1[0], a1[1]); pa.w = pk_bf16(a1[2], a1[3]);
            const bf16x8 fb = *(const bf16x8*)(TC + (16 * tc + fr) * 40 + fq * 8);
            f32x4 x = {0.f, 0.f, 0.f, 0.f};
            x = __builtin_amdgcn_mfma_f32_16x16x32_bf16(__builtin_bit_cast(bf16x8, pa), fb, x, 0, 0, 0);
            u32x2 w; w.x = pk_bf16(x[0], x[1]); w.y = pk_bf16(x[2], x[3]);
            *(u32x2*)(XT + (16 * tc + fr) * 40 + 16 * tr + fq * 4) = w;
        }
        __syncthreads();
        if (wid < 4) {
            const int tr = wid >> 1, tc = wid & 1;
            const bf16x8 fa = *(const bf16x8*)(TF + (32 + 16 * tr + fr) * 72 + 32 + fq * 8);
            const bf16x8 fb = *(const bf16x8*)(XT + (16 * tc + fr) * 40 + fq * 8);
            f32x4 x = {0.f, 0.f, 0.f, 0.f};
            x = __builtin_amdgcn_mfma_f32_16x16x32_bf16(fa, fb, x, 0, 0, 0);
#pragma unroll
            for (int jj = 0; jj < 4; ++jj) TF[(32 + 16 * tr + fq * 4 + jj) * 72 + 16 * tc + fr] = f2bf(-x[jj]);
        }
        __syncthreads();
        {
            const int i = tid >> 3, j0 = (tid & 7) * 8;
            const u32x4 v = *(const u32x4*)(TF + i * 72 + j0);
            const f32x4 s0 = *(const f32x4*)(sm + 192 + j0), s1 = *(const f32x4*)(sm + 192 + j0 + 4), b0 = *(const f32x4*)(sm + 64 + j0), b1 = *(const f32x4*)(sm + 64 + j0 + 4);
            const float tv[8] = {bf_lo(v.x), bf_hi(v.x), bf_lo(v.y), bf_hi(v.y), bf_lo(v.z), bf_hi(v.z), bf_lo(v.w), bf_hi(v.w)};
            u32x4 w1, w2;
            w1.x = pk_bf16(tv[0] * s0[0], tv[1] * s0[1]); w1.y = pk_bf16(tv[2] * s0[2], tv[3] * s0[3]); w1.z = pk_bf16(tv[4] * s1[0], tv[5] * s1[1]); w1.w = pk_bf16(tv[6] * s1[2], tv[7] * s1[3]);
            w2.x = pk_bf16(tv[0] * b0[0], tv[1] * b0[1]); w2.y = pk_bf16(tv[2] * b0[2], tv[3] * b0[3]); w2.z = pk_bf16(tv[4] * b1[0], tv[5] * b1[1]); w2.w = pk_bf16(tv[6] * b1[2], tv[7] * b1[3]);
            *(u32x4*)(T1 + i * 72 + j0) = w1; *(u32x4*)(T2 + i * 72 + j0) = w2;
        }
        __syncthreads();
        {
            bf16_t* W = (bf16_t*)(DI_ + D_W); bf16_t* UT = (bf16_t*)(DI_ + D_UT);
            bf16x8 fk[2], fv[2];
#pragma unroll
            for (int kk = 0; kk < 2; ++kk) { fk[kk] = *(const bf16x8*)(kT + (16 * wid + fr) * 72 + kk * 32 + fq * 8); fv[kk] = *(const bf16x8*)(vT + (16 * wid + fr) * 72 + kk * 32 + fq * 8); }
#pragma unroll
            for (int it = 0; it < 4; ++it) {
                f32x4 aw = {0.f, 0.f, 0.f, 0.f}, au = {0.f, 0.f, 0.f, 0.f};
#pragma unroll
                for (int kk = 0; kk < 2; ++kk) {
                    const bf16x8 f1 = *(const bf16x8*)(T1 + (16 * it + fr) * 72 + kk * 32 + fq * 8);
                    const bf16x8 f2 = *(const bf16x8*)(T2 + (16 * it + fr) * 72 + kk * 32 + fq * 8);
                    aw = __builtin_amdgcn_mfma_f32_16x16x32_bf16(fk[kk], f1, aw, 0, 0, 0);
                    au = __builtin_amdgcn_mfma_f32_16x16x32_bf16(f2, fv[kk], au, 0, 0, 0);
                }
                u32x2 ww; ww.x = pk_bf16(aw[0], aw[1]); ww.y = pk_bf16(aw[2], aw[3]);
                *(u32x2*)(W + (16 * it + fr) * 128 + 16 * wid + 4 * fq) = ww;
                u32x2 wu; wu.x = pk_bf16(au[0], au[1]); wu.y = pk_bf16(au[2], au[3]);
                *(u32x2*)(UT + (16 * wid + fr) * 64 + 16 * it + 4 * fq) = wu;
            }
        }
        __syncthreads();
    }
}

constexpr int SC_W = 0, SC_QG = 16896, SC_KDT = 33792, SC_QKM = 51200, SC_UT = 59904, SC_BUF = 77312;
DI void scan_fetch(const unsigned char* src, int t, u32x4 (&r)[9]) {
#pragma unroll
    for (int i = 0; i < 9; ++i) r[i] = __builtin_nontemporal_load((const u32x4*)(src + (size_t)(t + i * 512) * 16));
}
DI void scan_put(unsigned char* buf, int t, const u32x4 (&r)[9]) {
#pragma unroll
    for (int i = 0; i < 9; ++i) {
        const int q = t + i * 512;
        int off;
        if (i < 2) { off = SC_W + (q >> 4) * 264 + (q & 15) * 16; }
        else if (i < 4) { const int qq = q - 1024; off = SC_QG + (qq >> 4) * 264 + (qq & 15) * 16; }
        else if (i < 6) { const int qq = q - 2048; off = SC_KDT + (qq >> 3) * 136 + (qq & 7) * 16; }
        else if (i < 7) { const int qq = q - 3072; off = SC_QKM + (qq >> 3) * 136 + (qq & 7) * 16; }
        else { const int qq = q - 3584; off = SC_UT + (qq >> 3) * 136 + (qq & 7) * 16; }
        *(u32x2*)(buf + off) = (u32x2){r[i].x, r[i].y}; *(u32x2*)(buf + off + 8) = (u32x2){r[i].z, r[i].w};
    }
}
DI bf16x8 lda8(const unsigned char* base, int row, int col, int stride) {
    const s16x4 lo = *(const s16x4*)(base + row * stride + col * 2), hi = *(const s16x4*)(base + row * stride + col * 2 + 16);
    return __builtin_shufflevector(lo, hi, 0, 1, 2, 3, 4, 5, 6, 7);
}
DI bf16x8 pack8(const f32x16& x, int s) {
    u32x4 pk; pk.x = pk_bf16(x[8 * s], x[8 * s + 1]); pk.y = pk_bf16(x[8 * s + 2], x[8 * s + 3]); pk.z = pk_bf16(x[8 * s + 4], x[8 * s + 5]); pk.w = pk_bf16(x[8 * s + 6], x[8 * s + 7]);
    return __builtin_bit_cast(bf16x8, pk);
}
#define MFMA32(a, b, c) __builtin_amdgcn_mfma_f32_32x32x16_bf16((a), (b), (c), 0, 0, 0)
DI void scan_phase(const Params& p, unsigned char* lds) {
    int tid = threadIdx.x; asm volatile("" : "+v"(tid));
    const int wid = tid >> 6, lane = tid & 63, r = lane & 31, hh = lane >> 5;
    const int bh = blockIdx.x, b = bh >> 3, h = bh & 7, c0 = (wid & 3) * 32;
    const unsigned char* items = p.ws + OFF_Y + (size_t)bh * 32 * DITEM;
    const float* GAM = (const float*)(p.ws + OFF_GAM) + bh * 32;
    float* ORAW = (float*)(p.ws + OFF_ORAW);
    f32x16 Sacc[4];
#pragma unroll
    for (int d = 0; d < 4; ++d)
#pragma unroll
        for (int i = 0; i < 16; ++i) Sacc[d][i] = 0.f;
    u32x4 ra[9];
    scan_fetch(items, tid, ra); scan_put(lds, tid, ra); scan_fetch(items + DITEM, tid, ra);
    __syncthreads();
    for (int n = 0; n < 32; ++n) {
        const unsigned char* buf = lds + (n & 1) * SC_BUF;
        if (n + 1 < 32) scan_put(lds + ((n + 1) & 1) * SC_BUF, tid, ra);
        if (n + 2 < 32) scan_fetch(items + (size_t)(n + 2) * DITEM, tid, ra);
        if (wid < 4) {
            const float gam = GAM[n];
            bf16x8 Sb[4][2];
#pragma unroll
            for (int d = 0; d < 4; ++d) { Sb[d][0] = pack8(Sacc[d], 0); Sb[d][1] = pack8(Sacc[d], 1); }
            bf16x8 Vb[2][2];
#pragma unroll
            for (int mb = 0; mb < 2; ++mb) {
                f32x16 t;
#pragma unroll
                for (int i = 0; i < 16; ++i) t[i] = 0.f;
#pragma unroll
                for (int d = 0; d < 4; ++d)
#pragma unroll
                    for (int s = 0; s < 2; ++s) t = MFMA32(lda8(buf + SC_W, 32 * mb + r, 32 * d + 16 * s + 4 * hh, 264), Sb[d][s], t);
                f32x16 vn;
#pragma unroll
                for (int g = 0; g < 4; ++g) {
                    const u32x2 uu = *(const u32x2*)(buf + SC_UT + (c0 + r) * 136 + (32 * mb + 8 * g + 4 * hh) * 2);
                    vn[4 * g] = bf_lo(uu.x) - t[4 * g]; vn[4 * g + 1] = bf_hi(uu.x) - t[4 * g + 1]; vn[4 * g + 2] = bf_lo(uu.y) - t[4 * g + 2]; vn[4 * g + 3] = bf_hi(uu.y) - t[4 * g + 3];
                }
                Vb[mb][0] = pack8(vn, 0); Vb[mb][1] = pack8(vn, 1);
            }
#pragma unroll
            for (int mb = 0; mb < 2; ++mb) {
                f32x16 o;
#pragma unroll
                for (int i = 0; i < 16; ++i) o[i] = 0.f;
#pragma unroll
                for (int d = 0; d < 4; ++d)
#pragma unroll
                    for (int s = 0; s < 2; ++s) o = MFMA32(lda8(buf + SC_QG, 32 * mb + r, 32 * d + 16 * s + 4 * hh, 264), Sb[d][s], o);
#pragma unroll
                for (int jb = 0; jb <= mb; ++jb)
#pragma unroll
                    for (int s = 0; s < 2; ++s) o = MFMA32(lda8(buf + SC_QKM, 32 * mb + r, 32 * jb + 16 * s + 4 * hh, 136), Vb[jb][s], o);
                float* op = ORAW + ((size_t)b * 2048 + n * 64 + 32 * mb + 4 * hh) * 1024 + h * 128 + c0 + r;
#pragma unroll
                for (int i = 0; i < 16; ++i) op[(size_t)((i & 3) + 8 * (i >> 2)) * 1024] = o[i];
            }
#pragma unroll
            for (int d = 0; d < 4; ++d) {
#pragma unroll
                for (int i = 0; i < 16; ++i) Sacc[d][i] *= gam;
#pragma unroll
                for (int jb = 0; jb < 2; ++jb)
#pragma unroll
                    for (int s = 0; s < 2; ++s) Sacc[d] = MFMA32(lda8(buf + SC_KDT, 32 * d + r, 32 * jb + 16 * s + 4 * hh, 136), Vb[jb][s], Sacc[d]);
            }
        }
        __syncthreads();
    }
    if (wid < 4) {
        float* sp = p.out + O_S_P + ((size_t)bh * 128 + 4 * hh) * 128 + c0 + r;
#pragma unroll
        for (int d = 0; d < 4; ++d)
#pragma unroll
            for (int i = 0; i < 16; ++i) __builtin_nontemporal_store(Sacc[d][i], sp + (size_t)(32 * d + (i & 3) + 8 * (i >> 2)) * 128);
    }
}

DI void sample_phase(const Params& p, unsigned char* lds, int first, int stride) {
    int tid = threadIdx.x; asm volatile("" : "+v"(tid));
    const int wid = tid >> 6, lane = tid & 63;
    float* qS = (float*)lds; float* kS = qS + 1024; float* vS = kS + 1024; float* gS = vS + 1024; float* bS = gS + 8;
    float* red = (float*)(lds + 16384);
    float* ored = (float*)(lds + 32768);
    const bf16_t* PJ = (const bf16_t*)(p.ws + OFF_BIG); const float* AB = (const float*)(p.ws + OFF_AB);
    float* ORAW = (float*)(p.ws + OFF_ORAW);
    const int hl = wid >> 2, tok = wid & 3, cs = wid & 3, c4 = lane & 31, dh = lane >> 5;
    for (int item = first; item < 512; item += stride) {
        const int s = item >> 2, hp = item & 3, h = 2 * hp + hl, cb = h * 128 + 2 * lane;
        f32x2 hv[4][3]; unsigned pv[4][3]; f32x2 wv[4][3];
#pragma unroll
        for (int j = 0; j < 4; ++j) {
            const int idx = tok + j; const bool hist = idx < 3;
            const float* sp = p.state_conv_qkv + ((size_t)s * 3 + (hist ? idx : 0)) * 3072 + cb;
            const bf16_t* rp = PJ + (size_t)(MP + s * 4 + (hist ? 0 : idx - 3)) * NPROJ + 3072 + cb;
#pragma unroll
            for (int sg = 0; sg < 3; ++sg) { hv[j][sg] = *(const f32x2*)(sp + sg * 1024); pv[j][sg] = *(const unsigned*)(rp + sg * 1024); wv[j][sg] = *(const f32x2*)(p.conv_qkv_w + j * 3072 + sg * 1024 + cb); }
        }
        const size_t abrow = (size_t)MP + s * 4 + tok;
        const float ab_a = AB[abrow * 16 + h], ab_b = AB[abrow * 16 + 8 + h], alog = p.a_log[h], dtb = p.dt_bias[h];
        const float* Sin = p.state_delta + ((size_t)(s * 8 + h) * 128 + 32 * cs + 16 * dh) * 128 + 4 * c4;
        f32x4 S[16];
#pragma unroll
        for (int i = 0; i < 16; ++i) S[i] = __builtin_nontemporal_load((const f32x4*)(Sin + (size_t)i * 128));
        asm volatile("" ::: "memory");
        {
            float y[3][2];
#pragma unroll
            for (int sg = 0; sg < 3; ++sg) { float a0 = 0.f, a1 = 0.f;
#pragma unroll
                for (int j = 0; j < 4; ++j) { const bool hist = (tok + j) < 3; const float x0 = hist ? hv[j][sg].x : bf_lo(pv[j][sg]), x1 = hist ? hv[j][sg].y : bf_hi(pv[j][sg]);
                    a0 += wv[j][sg].x * x0; a1 += wv[j][sg].y * x1; }
                y[sg][0] = siluf_(a0); y[sg][1] = siluf_(a1); }
            const float sq = wave_sum(y[0][0] * y[0][0] + y[0][1] * y[0][1]), sk = wave_sum(y[1][0] * y[1][0] + y[1][1] * y[1][1]);
            const float rq = rsqrtf(sq + EPS) * 0.08838834764831845f, rk = rsqrtf(sk + EPS);
            const int o = (hl * 4 + tok) * 128 + 2 * lane;
            *(f32x2*)(qS + o) = (f32x2){y[0][0] * rq, y[0][1] * rq}; *(f32x2*)(kS + o) = (f32x2){y[1][0] * rk, y[1][1] * rk}; *(f32x2*)(vS + o) = (f32x2){y[2][0], y[2][1]};
            if (lane == 0) { gS[hl * 4 + tok] = -__expf(alog) * softplusf_(ab_a + dtb); bS[hl * 4 + tok] = sigmoidf_(ab_b); }
        }
        __syncthreads();
#pragma unroll
        for (int tk = 0; tk < 4; ++tk) {
            const float eg = __expf(gS[hl * 4 + tk]), bt = bS[hl * 4 + tk];
            const float* kp = kS + (hl * 4 + tk) * 128 + 32 * cs + 16 * dh; const float* qp = qS + (hl * 4 + tk) * 128 + 32 * cs + 16 * dh;
            f32x4 kv[4];
#pragma unroll
            for (int i4 = 0; i4 < 4; ++i4) kv[i4] = *(const f32x4*)(kp + 4 * i4);
            f32x4 rp = {0.f, 0.f, 0.f, 0.f};
#pragma unroll
            for (int i = 0; i < 16; ++i) rp += S[i] * kv[i >> 2][i & 3];
#pragma unroll
            for (int j = 0; j < 4; ++j) rp[j] += __shfl_xor(rp[j], 32);
            float* rb = red + ((tk * 2 + hl) * 4) * 128;
            if (dh == 0) *(f32x4*)(rb + cs * 128 + 4 * c4) = rp;
            __syncthreads();
            const f32x4 rr = (*(const f32x4*)(rb + 4 * c4) + *(const f32x4*)(rb + 128 + 4 * c4)) + (*(const f32x4*)(rb + 256 + 4 * c4) + *(const f32x4*)(rb + 384 + 4 * c4));
            const f32x4 vv = *(const f32x4*)(vS + (hl * 4 + tk) * 128 + 4 * c4);
            f32x4 vn;
#pragma unroll
            for (int j = 0; j < 4; ++j) vn[j] = bt * (vv[j] - eg * rr[j]);
            f32x4 qv[4];
#pragma unroll
            for (int i4 = 0; i4 < 4; ++i4) qv[i4] = *(const f32x4*)(qp + 4 * i4);
            f32x4 op = {0.f, 0.f, 0.f, 0.f};
#pragma unroll
            for (int i = 0; i < 16; ++i) { S[i] = S[i] * eg + vn * kv[i >> 2][i & 3]; op += S[i] * qv[i >> 2][i & 3]; }
#pragma unroll
            for (int j = 0; j < 4; ++j) op[j] += __shfl_xor(op[j], 32);
            if (dh == 0) *(f32x4*)(ored + ((tk * 2 + hl) * 4 + cs) * 128 + 4 * c4) = op;
        }
        float* Sout = p.out + O_S_S + ((size_t)(s * 8 + h) * 128 + 32 * cs + 16 * dh) * 128 + 4 * c4;
#pragma unroll
        for (int i = 0; i < 16; ++i) __builtin_nontemporal_store(S[i], (f32x4*)(Sout + (size_t)i * 128));
        __syncthreads();
        {
            const int o0 = tid * 2, tkk = o0 >> 8, hh2 = (o0 >> 7) & 1, cc = o0 & 127;
            const float* ob = ored + ((tkk * 2 + hh2) * 4) * 128 + cc;
            const f32x2 v = (*(const f32x2*)ob + *(const f32x2*)(ob + 128)) + (*(const f32x2*)(ob + 256) + *(const f32x2*)(ob + 384));
            *(f32x2*)(ORAW + ((size_t)MP + s * 4 + tkk) * 1024 + (2 * hp + hh2) * 128 + cc) = v;
        }
        __syncthreads();
    }
}

DI void gated_norm_phase(const Params& p) {
    const int tid = otid(), lane = tid & 63, gw = blockIdx.x * 8 + (tid >> 6), nw = gridDim.x * 8;
    const float* ORAW = (const float*)(p.ws + OFF_ORAW); const bf16_t* PJ = (const bf16_t*)(p.ws + OFF_BIG); bf16_t* YC = (bf16_t*)(p.ws + OFF_YC);
    for (int row = gw; row < MT; row += nw) {
        f32x4 o[4]; float ss = 0.f;
#pragma unroll
        for (int i = 0; i < 4; ++i) { o[i] = __builtin_nontemporal_load((const f32x4*)(ORAW + (size_t)row * 1024 + 16 * lane + 4 * i)); ss += o[i][0] * o[i][0] + o[i][1] * o[i][1] + o[i][2] * o[i][2] + o[i][3] * o[i][3]; }
        ss += __shfl_xor(ss, 1); ss += __shfl_xor(ss, 2); ss += __shfl_xor(ss, 4);
        const float rr = rsqrtf(ss * (1.0f / 128.0f) + EPS);
        const u32x4 z0 = *(const u32x4*)(PJ + (size_t)row * NPROJ + 6144 + 16 * lane), z1 = *(const u32x4*)(PJ + (size_t)row * NPROJ + 6144 + 16 * lane + 8);
        float y[16];
#pragma unroll
        for (int e = 0; e < 16; ++e) {
            const unsigned zz = e < 8 ? z0[e >> 1] : z1[(e - 8) >> 1];
            const float z = (e & 1) ? bf_hi(zz) : bf_lo(zz);
            y[e] = o[e >> 2][e & 3] * rr * p.dn_norm[(16 * lane + e) & 127] * siluf_(z);
        }
        u32x4 w0, w1; w0.x = pk_bf16(y[0], y[1]); w0.y = pk_bf16(y[2], y[3]); w0.z = pk_bf16(y[4], y[5]); w0.w = pk_bf16(y[6], y[7]);
        w1.x = pk_bf16(y[8], y[9]); w1.y = pk_bf16(y[10], y[11]); w1.z = pk_bf16(y[12], y[13]); w1.w = pk_bf16(y[14], y[15]);
        *(u32x4*)(YC + (size_t)row * DM + 1024 + 16 * lane) = w0; *(u32x4*)(YC + (size_t)row * DM + 1024 + 16 * lane + 8) = w1;
    }
}

#define XB_TMO      128
#define XB_XCNT(j)  (256  + 64 * (j))
#define XB_XSUB(j)  (1280 + 64 * (j))
#define XB_XGEN(j)  (2304 + 64 * (j))
#define XB_TOP      3328
#define XB_TOPGEN   3392
#define XCD_BAR_WORDS 3456
#define XB_SPIN_CAP (1u << 22)
DI unsigned xb_ld(unsigned* p)              { return __hip_atomic_load(p, __ATOMIC_RELAXED, __HIP_MEMORY_SCOPE_AGENT); }
DI unsigned xb_add(unsigned* p, unsigned v) { return __hip_atomic_fetch_add(p, v, __ATOMIC_RELAXED, __HIP_MEMORY_SCOPE_AGENT); }
DI unsigned xb_xcc_id() { return (unsigned)__builtin_amdgcn_s_getreg((3 << 11) | 20) & 0xFu; }
#define XB_SPIN(cond, bar) do { unsigned _sp = 0; while (cond) { __builtin_amdgcn_s_sleep(1); \
    if ((++_sp & 255u) == 0u) { if (xb_ld(&(bar)[XB_TMO])) break; if (_sp > XB_SPIN_CAP) { atomicAdd(&(bar)[XB_TMO], 1u); break; } } } } while (0)
struct XcdBarrier { unsigned* bar; unsigned x; volatile LAS unsigned* st; };
DI XcdBarrier xcd_barrier_post(unsigned* bar, volatile LAS unsigned* st) {
    XcdBarrier b; b.bar = bar; b.x = xb_xcc_id(); b.st = st;
    if (threadIdx.x == 0) (void)xb_add(&bar[XB_XCNT(b.x)], 1u);
    return b;
}
DI void xcd_barrier_complete(unsigned* bar, unsigned x, unsigned& nloc, unsigned& nx) {
    const unsigned G = gridDim.x * gridDim.y * gridDim.z;
    unsigned sum, cnt, mine, sp = 0u;
    for (;;) {
        sum = 0u; cnt = 0u; mine = 0u;
#pragma unroll
        for (unsigned j = 0; j < 16; ++j) { const unsigned c = xb_ld(&bar[XB_XCNT(j)]); sum += c; cnt += (c > 0u) ? 1u : 0u; mine = (j == x) ? c : mine; }
        if (sum == G) break;
        __builtin_amdgcn_s_sleep(1);
        if ((++sp & 255u) == 0u) { if (xb_ld(&bar[XB_TMO])) break; if (sp > XB_SPIN_CAP) { atomicAdd(&bar[XB_TMO], 1u); break; } }
    }
    nloc = mine > 0u ? mine : 1u; nx = cnt > 0u ? cnt : 1u;
}
DI void xcd_barrier(const XcdBarrier& b) {
    asm volatile("s_waitcnt vmcnt(0)" ::: "memory");
    __syncthreads();
    if (threadIdx.x == 0) {
        unsigned* bar = b.bar;
        __builtin_amdgcn_s_waitcnt(0);
        unsigned nloc = b.st[0], nx = b.st[1];
        if (nloc == 0u) { xcd_barrier_complete(bar, b.x, nloc, nx); b.st[0] = nloc; b.st[1] = nx; }
        const unsigned old = xb_add(&bar[XB_XSUB(b.x)], 1u);
        const unsigned gen = old / nloc;
        if (old + 1u == (gen + 1u) * nloc) {
            __builtin_amdgcn_fence(__ATOMIC_RELEASE, "agent");
            asm volatile("s_waitcnt vmcnt(0)" ::: "memory");
            const unsigned og = xb_add(&bar[XB_TOP], 1u);
            const unsigned tg = og / nx;
            if (og + 1u == (tg + 1u) * nx) xb_add(&bar[XB_TOPGEN], 1u);
            else XB_SPIN(xb_ld(&bar[XB_TOPGEN]) == tg, bar);
            __builtin_amdgcn_fence(__ATOMIC_ACQUIRE, "agent");
            xb_add(&bar[XB_XGEN(b.x)], 1u);
            asm volatile("s_waitcnt vmcnt(0)" ::: "memory");
        } else {
            XB_SPIN(xb_ld(&bar[XB_XGEN(b.x)]) == gen, bar);
            __builtin_amdgcn_fence(__ATOMIC_ACQUIRE, "agent");
            asm volatile("s_waitcnt vmcnt(0)" ::: "memory");
        }
    }
    __syncthreads();
}

__global__ void __launch_bounds__(512, 2) fwd_megakernel(Params p) {
    extern __shared__ __attribute__((aligned(16))) unsigned char shm[];
    cg::grid_group grid = cg::this_grid();
    LAS unsigned char* lds = (LAS unsigned char*)shm;
    unsigned char* ws = p.ws;
    if (threadIdx.x == 0) { *(volatile LAS unsigned*)(lds + LDS_MAIN) = 0u; *(volatile LAS unsigned*)(lds + LDS_MAIN + 4) = 0u; }
    __syncthreads();
    if (blockIdx.x == 0) { unsigned* bw = (unsigned*)(ws + OFF_BAR); for (int i = threadIdx.x; i < XCD_BAR_WORDS; i += 512) __hip_atomic_store(bw + i, 0u, __ATOMIC_RELAXED, __HIP_MEMORY_SCOPE_AGENT); }
    grid.sync();
    const XcdBarrier xb = xcd_barrier_post((unsigned*)(ws + OFF_BAR), (volatile LAS unsigned*)(lds + LDS_MAIN));
    bf16_t* H = (bf16_t*)(ws + OFF_H); bf16_t* YC = (bf16_t*)(ws + OFF_YC); bf16_t* BIG = (bf16_t*)(ws + OFF_BIG); bf16_t* Y = (bf16_t*)(ws + OFF_Y);
    DUP(1) {
        conv_phase(p, (unsigned*)shm, 0, CT_P0, (int)blockIdx.x, (int)gridDim.x);
        bf16_t* PBF = (bf16_t*)(ws + OFF_PBF);
        for (int it = blockIdx.x * 512 + otid(); it < MT * DPLE / 4; it += gridDim.x * 512) {
            const int e = it * 4; const float* sp = e < MP * DPLE ? p.p_prompt + e : p.p_sample + (e - MP * DPLE);
            const f32x4 v = __builtin_nontemporal_load((const f32x4*)sp); u32x2 w; w.x = pk_bf16(v[0], v[1]); w.y = pk_bf16(v[2], v[3]); *(u32x2*)(PBF + e) = w;
        }
        row_phase(p, 0);
    }
    xcd_barrier(xb);
    DUP(2) run_gemm(lds, H, (const bf16_t*)(ws + OFF_WGU1), MT, 11264, 2048, pg8::EpiSwiglu{BIG});
    tail_conv(p, (unsigned*)shm, 34 * 44, CT_P0, CT_WD1);
    xcd_barrier(xb);
    DUP(3) run_gemm(lds, BIG, (const bf16_t*)(ws + OFF_WD1), MP, 2048, 5632, pg8::EpiY{Y, DM});
    DUP(4) small_gemm<0>(shm, BIG + (size_t)MP * FF, (const bf16_t*)(ws + OFF_WD1), 5632, Y + (size_t)MP * DM);
    xcd_barrier(xb);
    row_phase(p, 1);
    xcd_barrier(xb);
    DUP(5) run_gemm(lds, H, (const bf16_t*)(ws + OFF_WIN), MT, NINP, 2048, pg8::EpiProj{BIG, (float*)(ws + OFF_AB)});
    tail_conv(p, (unsigned*)shm, 34 * 29, CT_WD1, CT_MISC);
    xcd_barrier(xb);
    prep_phase(p, shm);
    xcd_barrier(xb);
    DUP(8) { if (blockIdx.x < 32) scan_phase(p, shm); else { sample_phase(p, shm, (int)blockIdx.x - 32, (int)gridDim.x - 32); mixer_a_phase(p);
             conv_phase(p, (unsigned*)shm, CT_MISC, CT_SHADOW, (int)blockIdx.x - 32, (int)gridDim.x - 32); } }
    XDUP(9) { if (blockIdx.x < 32) scan_phase(p, shm); }
    XDUP(15) { if (blockIdx.x >= 32) sample_phase(p, shm, (int)blockIdx.x - 32, (int)gridDim.x - 32); }
    XDUP(16) { if (blockIdx.x >= 32) mixer_a_phase(p); }
    xcd_barrier(xb);
    DUP(10) gated_norm_phase(p);
    XDUP(11) { xcd_barrier(xb); xcd_barrier(xb); xcd_barrier(xb); xcd_barrier(xb); xcd_barrier(xb); }
    xcd_barrier(xb);
    run_gemm(lds, YC, (const bf16_t*)(ws + OFF_WOUT), MP, 2048, 2048, pg8::EpiY{Y, DM});
    small_gemm<0>(shm, YC + (size_t)MP * DM, (const bf16_t*)(ws + OFF_WOUT), 2048, Y + (size_t)MP * DM);
    xcd_barrier(xb);
    row_phase(p, 2);
    XDUP(13) { xcd_barrier(xb); row_phase(p, 2, true); row_phase(p, 2, true); }
    xcd_barrier(xb);
    run_gemm(lds, H, (const bf16_t*)(ws + OFF_WGU2), MT, 11264, 2048, pg8::EpiSwiglu{BIG});
    tail_conv(p, (unsigned*)shm, 34 * 44, CT_SHADOW, CONV_TILES);
    xcd_barrier(xb);
    run_gemm(lds, BIG, (const bf16_t*)(ws + OFF_WD2), MP, 2048, 5632, pg8::EpiY{Y, DM});
    small_gemm<0>(shm, BIG + (size_t)MP * FF, (const bf16_t*)(ws + OFF_WD2), 5632, Y + (size_t)MP * DM);
    xcd_barrier(xb);
    row_phase(p, 3);
    xcd_barrier(xb);
    run_gemm(lds, (const bf16_t*)(ws + OFF_PBF), (const bf16_t*)(ws + OFF_WPP), MP, 2048, 256, pg8::EpiY{Y, DM});
    run_gemm(lds, H, (const bf16_t*)(ws + OFF_WPG), MP, 2048, 2048, pg8::EpiGate{Y, DM});
    small_gemm<0>(shm, (const bf16_t*)(ws + OFF_PBF) + (size_t)MP * DPLE, (const bf16_t*)(ws + OFF_WPP), 256, Y + (size_t)MP * DM);
    small_gemm<1>(shm, H + (size_t)MP * DM, (const bf16_t*)(ws + OFF_WPG), 2048, Y + (size_t)MP * DM);
    xcd_barrier(xb);
    row_phase(p, 4);
}

extern "C" void kernel_launch(void* const* d_in, const int* in_sizes, int n_in, void* d_out, int out_size, void* d_ws, size_t ws_size, hipStream_t stream) {
    static int grid_blocks = 0;
    if (grid_blocks == 0) {
        if (n_in != 30 || ws_size < WS_END || out_size != 36614144) { fprintf(stderr, "kernel_launch: unexpected shapes (n_in %d, ws %zu need %zu, out %d)\n", n_in, ws_size, (size_t)WS_END, out_size); grid_blocks = -1; return; }
        int dev = 0, cus = 0, per_cu = 0;
        hipGetDevice(&dev);
        hipDeviceGetAttribute(&cus, hipDeviceAttributeMultiprocessorCount, dev);
        if (hipFuncSetAttribute((const void*)fwd_megakernel, hipFuncAttributeMaxDynamicSharedMemorySize, LDS_BYTES) != hipSuccess) { fprintf(stderr, "kernel_launch: hipFuncSetAttribute failed\n"); grid_blocks = -1; return; }
        hipOccupancyMaxActiveBlocksPerMultiprocessor(&per_cu, (const void*)fwd_megakernel, 512, LDS_BYTES);
        if (per_cu < 1) { fprintf(stderr, "kernel_launch: occupancy query says %d blocks/CU\n", per_cu); per_cu = 1; }
        if (cus < 256) { fprintf(stderr, "kernel_launch: built for a 256-CU device, found %d CUs; nothing launched\n", cus); grid_blocks = -1; return; }
        grid_blocks = 256;
    }
    if (grid_blocks < 0) return;
    Params p{};
    const float** pp = (const float**)&p;
    for (int i = 0; i < 30; ++i) pp[i] = (const float*)d_in[i];
    p.out = (float*)d_out; p.ws = (unsigned char*)d_ws;
    void* args[] = {&p};
    hipError_t e = hipLaunchCooperativeKernel((const void*)fwd_megakernel, dim3(grid_blocks), dim3(512), args, LDS_BYTES, stream);
    if (e != hipSuccess) fprintf(stderr, "cooperative launch failed: %s (grid %d)\n", hipGetErrorString(e), grid_blocks);
}
```

```cpp
#include <hip/hip_runtime.h>
#include <hip/hip_cooperative_groups.h>
#include <cstdio>
namespace cg = cooperative_groups;

#define LAS __attribute__((address_space(3)))
#define DI __device__ __forceinline__
typedef unsigned short bf16_t;
typedef short bf16x8 __attribute__((ext_vector_type(8)));
typedef short s16x4 __attribute__((ext_vector_type(4)));
typedef float f32x2 __attribute__((ext_vector_type(2)));
typedef float f32x4 __attribute__((ext_vector_type(4)));
typedef float f32x16 __attribute__((ext_vector_type(16)));
typedef unsigned u32x2 __attribute__((ext_vector_type(2)));
typedef unsigned u32x4 __attribute__((ext_vector_type(4)));
typedef __bf16 bf16v2 __attribute__((ext_vector_type(2)));

constexpr int MP = 8192, MS = 512, MT = 8704, DM = 2048, FF = 5632, NPROJ = 7168, NINP = 7424, NINR = 7184, DPLE = 256;
constexpr float EPS = 1e-6f;
constexpr size_t O_Y = 0, O_CA_P = 17825792, O_CQ_P = 17833984, O_S_P = 17870848, O_CA_S = 18395136, O_CQ_S = 18657280, O_S_S = 19836928;
constexpr size_t SZ_WGU = 11264ull * 2048 * 2, SZ_WD = 2048ull * 5632 * 2, SZ_WIN = 7424ull * 2048 * 2, SZ_W2K = 2048ull * 2048 * 2, SZ_WPP = 2048ull * 256 * 2;
constexpr size_t OFF_WGU1 = 0, OFF_WD1 = OFF_WGU1 + SZ_WGU, OFF_WIN = OFF_WD1 + SZ_WD, OFF_WOUT = OFF_WIN + SZ_WIN, OFF_WGU2 = OFF_WOUT + SZ_W2K,
                 OFF_WD2 = OFF_WGU2 + SZ_WGU, OFF_WPG = OFF_WD2 + SZ_WD, OFF_WPP = OFF_WPG + SZ_W2K, OFF_H = OFF_WPP + SZ_WPP,
                 OFF_YC = OFF_H + 35651584ull, OFF_PBF = OFF_YC + 35651584ull, OFF_BIG = OFF_PBF + 4456448ull, OFF_Y = OFF_BIG + 124780544ull,
                 OFF_AB = OFF_Y + 75501568ull, OFF_BAR = OFF_AB + 557056ull, OFF_ORAW = OFF_BAR + 16384ull, OFF_RINV = OFF_ORAW + 35651584ull, WS_END = OFF_RINV + 36864ull;
constexpr size_t DITEM = 73728, D_W = 0, D_QG = 16384, D_KDT = 32768, D_QKM = 49152, D_UT = 57344, OFF_GAM = OFF_Y + 1024ull * DITEM;
constexpr int LDS_MAIN = 154624, LDS_BYTES = LDS_MAIN + 16;
#ifndef PROBE_DUP
#define PROBE_DUP 0
#endif
#define DUP(n) for (int _d = 0; _d < ((PROBE_DUP == (n)) ? 2 : 1); ++_d)
#define XDUP(n) for (int _d = 0; _d < ((PROBE_DUP == (n)) ? 1 : 0); ++_d)

struct Params {
    const float *x_prompt, *x_sample, *state_conv_a, *state_conv_qkv, *state_delta, *p_prompt, *p_sample;
    const float *f1_pre, *f1_post, *f1_wg, *f1_wu, *f1_wd;
    const float *mix_pre, *mix_post, *w_in, *conv_a_w, *conv_qkv_w, *a_log, *dt_bias, *dn_norm, *w_out;
    const float *f2_pre, *f2_post, *f2_wg, *f2_wu, *f2_wd;
    const float *ple_pre, *ple_post, *w_ple_gate, *w_ple_proj;
    float* out; unsigned char* ws;
};

DI unsigned pk_bf16(float lo, float hi) { f32x2 f = {lo, hi}; bf16v2 b = __builtin_convertvector(f, bf16v2); return __builtin_bit_cast(unsigned, b); }
DI float bf_lo(unsigned u) { return __uint_as_float(u << 16); }
DI float bf_hi(unsigned u) { return __uint_as_float(u & 0xffff0000u); }
DI float bf2f(bf16_t b) { return __uint_as_float(((unsigned)b) << 16); }
DI float dpp_f(float v, const int ctrl_sel) {
    const int x = __float_as_int(v);
    int r;
    if (ctrl_sel == 0) r = __builtin_amdgcn_update_dpp(x, x, 0xB1, 0xF, 0xF, true);
    else if (ctrl_sel == 1) r = __builtin_amdgcn_update_dpp(x, x, 0x4E, 0xF, 0xF, true);
    else if (ctrl_sel == 2) r = __builtin_amdgcn_update_dpp(x, x, 0x141, 0xF, 0xF, true);
    else r = __builtin_amdgcn_update_dpp(x, x, 0x140, 0xF, 0xF, true);
    return __int_as_float(r);
}
DI float wave_sum(float v) {
    v += dpp_f(v, 0); v += dpp_f(v, 1); v += dpp_f(v, 2); v += dpp_f(v, 3);
    const int x = __float_as_int(v);
    return __int_as_float(__builtin_amdgcn_readlane(x, 0)) + __int_as_float(__builtin_amdgcn_readlane(x, 16)) + __int_as_float(__builtin_amdgcn_readlane(x, 32)) + __int_as_float(__builtin_amdgcn_readlane(x, 48));
}
DI int otid() { int t = threadIdx.x; asm volatile("" : "+v"(t)); return t; }
DI float sigmoidf_(float x) { return __builtin_amdgcn_rcpf(1.0f + __expf(-x)); }
DI float siluf_(float x) { return x * sigmoidf_(x); }

namespace pg8 {
constexpr int BM = 256, BK = 64, HALF = 128, HTB = HALF * BK * 2, STAGE_BYTES = 8 * HTB, NXCD = 8, WGM = 8;
DI int lds_byte(int r, int c) { const int st = (r >> 4) * 2 + (c >> 5), rr = r & 15, cc = c & 31, ob = rr * 64 + cc * 2; return st * 1024 + (ob ^ (((ob >> 9) & 1) << 5)); }
DI void stage_rc(int b, int& R, int& C) { const int st = b / 1024, sb = b % 1024, swz = sb ^ (((sb >> 9) & 1) << 5); R = (st >> 1) * 16 + swz / 64; C = (st & 1) * 32 + (swz % 64) / 2; }
DI int perm32(int rho) { const int n = rho >> 4, i = rho & 15; return 8 * (i >> 2) + 4 * n + (i & 3); }
struct Unit { int pm, pn; };
struct Gemm { const bf16_t* A; const bf16_t* Bt; int M, N, K; };
struct StaticOrder {
    int nM, nN, nwg, G, c;
    DI void init(int M, int N, int G_, int c_) { nM = M / BM; nN = N / BM; nwg = nM * nN; G = G_; c = c_; }
    DI bool next(int i, Unit& u) const {
        const long L = (long)i * G + c; if (L >= nwg) return false;
        int wgid = (int)L; { const int q = nwg / NXCD, r = nwg % NXCD, xcd = wgid % NXCD, off = wgid / NXCD; wgid = (xcd < r ? xcd * (q + 1) : r * (q + 1) + (xcd - r) * q) + off; }
        const int nig = WGM * nN, gid = wgid / nig, fm = gid * WGM, gsz = (nM - fm) < WGM ? (nM - fm) : WGM;
        u.pm = fm + ((wgid % nig) % gsz); u.pn = (wgid % nig) / gsz; return true;
    }
};
struct EpiY {
    static constexpr bool PERM = true;
    bf16_t* C; int ldc;
    DI void operator()(const f32x4 (&acc)[2][2][4][2], const Unit& u, int wr, int wc, int fr, int fq) const {
        const int row0 = u.pm * BM + wr * 64 + fr, col0 = u.pn * BM + wc * 32 + 8 * fq;
#pragma unroll
        for (int ai = 0; ai < 2; ++ai)
#pragma unroll
            for (int m = 0; m < 4; ++m) { bf16_t* rowp = C + (size_t)(row0 + ai * HALF + m * 16) * ldc + col0;
#pragma unroll
                for (int bj = 0; bj < 2; ++bj) { const f32x4 v0 = acc[ai][bj][m][0], v1 = acc[ai][bj][m][1];
                    u32x4 w; w.x = pk_bf16(v0[0], v0[1]); w.y = pk_bf16(v0[2], v0[3]); w.z = pk_bf16(v1[0], v1[1]); w.w = pk_bf16(v1[2], v1[3]);
                    *(u32x4*)(rowp + bj * HALF) = w; } }
    }
};
struct EpiGate {
    static constexpr bool PERM = true;
    bf16_t* C; int ldc;
    DI void operator()(const f32x4 (&acc)[2][2][4][2], const Unit& u, int wr, int wc, int fr, int fq) const {
        const int row0 = u.pm * BM + wr * 64 + fr, col0 = u.pn * BM + wc * 32 + 8 * fq;
#pragma unroll
        for (int ai = 0; ai < 2; ++ai)
#pragma unroll
            for (int m = 0; m < 4; ++m) { bf16_t* rowp = C + (size_t)(row0 + ai * HALF + m * 16) * ldc + col0;
#pragma unroll
                for (int bj = 0; bj < 2; ++bj) { const f32x4 v0 = acc[ai][bj][m][0], v1 = acc[ai][bj][m][1];
                    const u32x4 pp = *(const u32x4*)(rowp + bj * HALF);
                    u32x4 w; w.x = pk_bf16(sigmoidf_(v0[0]) * bf_lo(pp.x), sigmoidf_(v0[1]) * bf_hi(pp.x)); w.y = pk_bf16(sigmoidf_(v0[2]) * bf_lo(pp.y), sigmoidf_(v0[3]) * bf_hi(pp.y));
                    w.z = pk_bf16(sigmoidf_(v1[0]) * bf_lo(pp.z), sigmoidf_(v1[1]) * bf_hi(pp.z)); w.w = pk_bf16(sigmoidf_(v1[2]) * bf_lo(pp.w), sigmoidf_(v1[3]) * bf_hi(pp.w));
                    *(u32x4*)(rowp + bj * HALF) = w; } }
    }
};
struct EpiSwiglu {
    static constexpr bool PERM = true;
    bf16_t* O;
    DI void operator()(const f32x4 (&acc)[2][2][4][2], const Unit& u, int wr, int wc, int fr, int fq) const {
        const int row0 = u.pm * BM + wr * 64 + fr, col0 = u.pn * 128 + wc * 32 + 8 * fq;
#pragma unroll
        for (int ai = 0; ai < 2; ++ai)
#pragma unroll
            for (int m = 0; m < 4; ++m) { bf16_t* rowp = O + (size_t)(row0 + ai * HALF + m * 16) * FF + col0;
                float v[8];
#pragma unroll
                for (int n = 0; n < 2; ++n) { const f32x4 g = acc[ai][0][m][n], uu = acc[ai][1][m][n];
#pragma unroll
                    for (int j = 0; j < 4; j += 2) {
                        const float e0 = 1.0f + __expf(-fmaxf(g[j], -30.f)), e1 = 1.0f + __expf(-fmaxf(g[j + 1], -30.f));
                        const float r = __builtin_amdgcn_rcpf(e0 * e1);
                        v[4 * n + j] = g[j] * uu[j] * (r * e1); v[4 * n + j + 1] = g[j + 1] * uu[j + 1] * (r * e0); } }
                u32x4 w; w.x = pk_bf16(v[0], v[1]); w.y = pk_bf16(v[2], v[3]); w.z = pk_bf16(v[4], v[5]); w.w = pk_bf16(v[6], v[7]);
                *(u32x4*)rowp = w; }
    }
};
struct EpiProj {
    static constexpr bool PERM = true;
    bf16_t* O; float* AB;
    DI void operator()(const f32x4 (&acc)[2][2][4][2], const Unit& u, int wr, int wc, int fr, int fq) const {
        const int row0 = u.pm * BM + wr * 64 + fr;
        if (u.pn < 28) {
            const int col0 = u.pn * BM + wc * 32 + 8 * fq;
#pragma unroll
            for (int ai = 0; ai < 2; ++ai)
#pragma unroll
                for (int m = 0; m < 4; ++m) { bf16_t* rowp = O + (size_t)(row0 + ai * HALF + m * 16) * NPROJ + col0;
#pragma unroll
                    for (int bj = 0; bj < 2; ++bj) { const f32x4 v0 = acc[ai][bj][m][0], v1 = acc[ai][bj][m][1];
                        u32x4 w; w.x = pk_bf16(v0[0], v0[1]); w.y = pk_bf16(v0[2], v0[3]); w.z = pk_bf16(v1[0], v1[1]); w.w = pk_bf16(v1[2], v1[3]);
                        *(u32x4*)(rowp + bj * HALF) = w; } }
        } else if (wc == 0 && fq < 2) {
#pragma unroll
            for (int ai = 0; ai < 2; ++ai)
#pragma unroll
                for (int m = 0; m < 4; ++m) { float* rowp = AB + (size_t)(row0 + ai * HALF + m * 16) * 16 + 8 * fq;
                    *(f32x4*)(rowp) = acc[ai][0][m][0]; *(f32x4*)(rowp + 4) = acc[ai][0][m][1]; }
        }
    }
};

template <class Epi>
DI void gemm_phase(LAS unsigned char* lds, const Gemm g, const StaticOrder& S, const Epi& E) {
    int tid = threadIdx.x; asm volatile("" : "+v"(tid));
    const int wid = __builtin_amdgcn_readfirstlane(tid >> 6), lane = tid & 63, wr = wid >> 2, wc = wid & 3, fr = lane & 15, fq = lane >> 4;
    const int K = g.K, nt = K / BK;
    unsigned voffA[2], voffB[2];
#pragma unroll
    for (int i = 0; i < 2; ++i) { int R, C; stage_rc(tid * 16 + i * 8192, R, C); const int Rb = Epi::PERM ? ((R & ~31) + perm32(R & 31)) : R;
        voffA[i] = (unsigned)(R * K + C) * 2u; voffB[i] = (unsigned)(Rb * K + C) * 2u; }
    const size_t kstep = (size_t)(BK * 2);
    const size_t hstep = (size_t)HALF * K * 2;
    const size_t tstep = 2 * hstep;
    const unsigned ldsw = (unsigned)wid * 1024u;
    const int aoff = lds_byte(wr * 64 + fr, fq * 8), boff = lds_byte(wc * 32 + fr, fq * 8);
#define PG8_SA(b, h) (((b) * 2 + (h)) * HTB)
#define PG8_SB(b, h) ((4 + (b) * 2 + (h)) * HTB)
#define PG8_STAGE(bufoff, gbase, voff) do { _Pragma("unroll") for (int _i = 0; _i < 2; ++_i) \
        __builtin_amdgcn_global_load_lds((const unsigned*)((const char*)(gbase) + (voff)[_i]), (LAS unsigned*)(lds + (bufoff) + ldsw + _i * 8192), 16, 0, 0); } while (0)
#define PG8_LDA(dst, b, h) do { _Pragma("unroll") for (int m = 0; m < 4; ++m) _Pragma("unroll") for (int k = 0; k < 2; ++k) dst[m][k] = *(const LAS bf16x8*)(lds + PG8_SA(b, h) + aoff + m * 2048 + k * 1024); } while (0)
#define PG8_LDB(dst, b, h) do { _Pragma("unroll") for (int n = 0; n < 2; ++n) _Pragma("unroll") for (int k = 0; k < 2; ++k) dst[n][k] = *(const LAS bf16x8*)(lds + PG8_SB(b, h) + boff + n * 2048 + k * 1024); } while (0)
#define PG8_MMA(ai, bj, At, Bt) do { __builtin_amdgcn_s_setprio(1); _Pragma("unroll") for (int m = 0; m < 4; ++m) _Pragma("unroll") for (int n = 0; n < 2; ++n) _Pragma("unroll") for (int k = 0; k < 2; ++k) \
        acc[ai][bj][m][n] = __builtin_amdgcn_mfma_f32_16x16x32_bf16(Bt[n][k], At[m][k], acc[ai][bj][m][n], 0, 0, 0); __builtin_amdgcn_s_setprio(0); } while (0)
#define PG8_WAIT_V(n) asm volatile("s_waitcnt vmcnt(" #n ")" ::: "memory")
#define PG8_WAIT_L(n) asm volatile("s_waitcnt lgkmcnt(" #n ")" ::: "memory")
#define PG8_BAR __builtin_amdgcn_s_barrier()
#define PG8_SCHED __builtin_amdgcn_sched_barrier(0)
    Unit cur, nxt; int ui = 0;
    if (!S.next(0, cur)) return;
    f32x4 acc[2][2][4][2];
#pragma unroll
    for (int a = 0; a < 2; ++a)
#pragma unroll
        for (int b = 0; b < 2; ++b)
#pragma unroll
            for (int m = 0; m < 4; ++m)
#pragma unroll
                for (int n = 0; n < 2; ++n) acc[a][b][m][n] = (f32x4){0.f, 0.f, 0.f, 0.f};
    bf16x8 At[4][2], B0[2][2], B1[2][2];
    const char* cA = (const char*)g.A + (size_t)cur.pm * tstep; const char* cB = (const char*)g.Bt + (size_t)cur.pn * tstep;
    PG8_STAGE(PG8_SB(0, 0), cB, voffB); PG8_STAGE(PG8_SA(0, 0), cA, voffA); PG8_STAGE(PG8_SB(0, 1), cB + hstep, voffB); PG8_STAGE(PG8_SA(0, 1), cA + hstep, voffA);
    if (wr == 1) PG8_BAR;
    PG8_WAIT_V(4); PG8_BAR;
    PG8_STAGE(PG8_SB(1, 0), cB + kstep, voffB); PG8_STAGE(PG8_SA(1, 0), cA + kstep, voffA); PG8_STAGE(PG8_SB(1, 1), cB + hstep + kstep, voffB);
    PG8_WAIT_V(6); PG8_BAR;
    for (;;) {
        const bool has_next = S.next(ui + 1, nxt);
        const char* nA = has_next ? (const char*)g.A + (size_t)nxt.pm * tstep : cA; const char* nB = has_next ? (const char*)g.Bt + (size_t)nxt.pn * tstep : cB;
        for (int t = 0; t < nt; t += 2) {
            const bool last = (t == nt - 2);
            const char* a1 = cA + (size_t)(t + 1) * kstep;
            const char* a2 = last ? nA : cA + (size_t)(t + 2) * kstep; const char* b2 = last ? nB : cB + (size_t)(t + 2) * kstep;
            const char* a3 = a2 + kstep; const char* b3 = b2 + kstep;
            PG8_LDB(B0, 0, 0); PG8_SCHED; PG8_LDA(At, 0, 0); PG8_STAGE(PG8_SA(1, 1), a1 + hstep, voffA);
            PG8_WAIT_L(8); PG8_BAR; PG8_WAIT_L(0); PG8_MMA(0, 0, At, B0); PG8_BAR; PG8_SCHED;
            PG8_LDB(B1, 0, 1); PG8_STAGE(PG8_SB(0, 0), b2, voffB);
            PG8_BAR; PG8_WAIT_L(0); PG8_MMA(0, 1, At, B1); PG8_BAR;
            PG8_LDA(At, 0, 1); PG8_STAGE(PG8_SA(0, 0), a2, voffA);
            PG8_BAR; PG8_WAIT_L(0); PG8_MMA(1, 0, At, B0); PG8_BAR; PG8_SCHED;
            PG8_STAGE(PG8_SB(0, 1), b2 + hstep, voffB);
            PG8_WAIT_V(6); PG8_BAR; PG8_MMA(1, 1, At, B1); PG8_BAR;
            PG8_LDB(B0, 1, 0); PG8_SCHED; PG8_LDA(At, 1, 0); PG8_STAGE(PG8_SA(0, 1), a2 + hstep, voffA);
            PG8_WAIT_L(8); PG8_BAR; PG8_WAIT_L(0); PG8_MMA(0, 0, At, B0); PG8_BAR; PG8_SCHED;
            PG8_LDB(B1, 1, 1); PG8_STAGE(PG8_SB(1, 0), b3, voffB);
            PG8_BAR; PG8_WAIT_L(0); PG8_MMA(0, 1, At, B1); PG8_BAR;
            PG8_LDA(At, 1, 1); PG8_STAGE(PG8_SA(1, 0), a3, voffA);
            PG8_BAR; PG8_WAIT_L(0); PG8_MMA(1, 0, At, B0); PG8_BAR; PG8_SCHED;
            PG8_STAGE(PG8_SB(1, 1), b3 + hstep, voffB);
            PG8_WAIT_V(6); PG8_BAR; PG8_MMA(1, 1, At, B1); PG8_BAR;
        }
        E(acc, cur, wr, wc, fr, fq);
        if (!has_next) break;
#pragma unroll
        for (int a = 0; a < 2; ++a)
#pragma unroll
            for (int b = 0; b < 2; ++b)
#pragma unroll
                for (int m = 0; m < 4; ++m)
#pragma unroll
                    for (int n = 0; n < 2; ++n) acc[a][b][m][n] = (f32x4){0.f, 0.f, 0.f, 0.f};
        cur = nxt; cA = nA; cB = nB; ++ui;
    }
    PG8_WAIT_V(0);
    if (wr == 0) PG8_BAR;
    PG8_BAR;
#undef PG8_SA
#undef PG8_SB
#undef PG8_STAGE
#undef PG8_LDA
#undef PG8_LDB
#undef PG8_MMA
#undef PG8_WAIT_V
#undef PG8_WAIT_L
#undef PG8_BAR
#undef PG8_SCHED
}
}

template <class Epi>
DI void run_gemm(LAS unsigned char* lds, const bf16_t* A, const bf16_t* Bt, int M, int N, int K, const Epi& E) {
    pg8::Gemm g{A, Bt, M, N, K}; pg8::StaticOrder S; S.init(M, N, (int)gridDim.x, (int)blockIdx.x);
    pg8::gemm_phase<Epi>(lds, g, S, E);
}

template <int MODE>
DI void small_gemm(unsigned char* lds, const bf16_t* __restrict__ A, const bf16_t* __restrict__ Bt, int K, bf16_t* Yrows) {
    const int tid = otid(), wid = tid >> 6, lane = tid & 63, fr = lane & 15, fq = lane >> 4;
    const int wm = wid >> 1, wn = wid & 1, nk = K >> 7;
    const int lr = tid >> 4, lc = tid & 15;
    constexpr int RS = 272, BUF = 64 * RS;
    for (int tile = blockIdx.x; tile < 256; tile += gridDim.x) {
        const int ms = tile >> 5, ns = tile & 31;
        const bf16_t* ap = A + (size_t)(ms * 64 + lr) * K + lc * 8;
        const bf16_t* bp = Bt + (size_t)(ns * 64 + lr) * K + lc * 8;
        const size_t r32 = (size_t)32 * K;
        u32x4 ra[4][2], rb[4][2];
#define SG_LOAD(j, t) do { if ((t) < nk) { ra[j][0] = *(const u32x4*)(ap + (t) * 128); ra[j][1] = *(const u32x4*)(ap + r32 + (t) * 128); rb[j][0] = *(const u32x4*)(bp + (t) * 128); rb[j][1] = *(const u32x4*)(bp + r32 + (t) * 128); } } while (0)
#define SG_WRITE(j, t) do { if ((t) < nk) { unsigned char* d = lds + ((t) & 1) * (2 * BUF) + lr * RS + lc * 16; \
        *(u32x4*)d = ra[j][0]; *(u32x4*)(d + 32 * RS) = ra[j][1]; *(u32x4*)(d + BUF) = rb[j][0]; *(u32x4*)(d + BUF + 32 * RS) = rb[j][1]; } } while (0)
#define SG_COMPUTE(t) do { const unsigned char* bA = lds + ((t) & 1) * (2 * BUF) + (16 * wm + fr) * RS + fq * 16; const unsigned char* bB = lds + ((t) & 1) * (2 * BUF) + BUF + (32 * wn + fr) * RS + fq * 16; \
        _Pragma("unroll") for (int kk = 0; kk < 4; ++kk) { const bf16x8 fa = *(const bf16x8*)(bA + kk * 64), f0 = *(const bf16x8*)(bB + kk * 64), f1 = *(const bf16x8*)(bB + 16 * RS + kk * 64); \
            acc0 = __builtin_amdgcn_mfma_f32_16x16x32_bf16(f0, fa, acc0, 0, 0, 0); acc1 = __builtin_amdgcn_mfma_f32_16x16x32_bf16(f1, fa, acc1, 0, 0, 0); } } while (0)
#define SG_STEP(j, t) do { if ((t) < nk) { __syncthreads(); SG_COMPUTE(t); SG_WRITE(((j) + 1) & 3, (t) + 1); SG_LOAD(j, (t) + 4); } } while (0)
        f32x4 acc0 = {0.f, 0.f, 0.f, 0.f}, acc1 = {0.f, 0.f, 0.f, 0.f};
        SG_LOAD(0, 0); SG_LOAD(1, 1); SG_LOAD(2, 2); SG_LOAD(3, 3);
        SG_WRITE(0, 0);
        for (int t = 0; t < nk; t += 4) { SG_STEP(0, t); SG_STEP(1, t + 1); SG_STEP(2, t + 2); SG_STEP(3, t + 3); }
#undef SG_LOAD
#undef SG_WRITE
#undef SG_COMPUTE
#undef SG_STEP
        bf16_t* yp = Yrows + (size_t)(ms * 64 + 16 * wm + fr) * DM + ns * 64 + 32 * wn + 4 * fq;
        if (MODE == 1) {
            const u32x2 p0 = *(const u32x2*)yp, p1 = *(const u32x2*)(yp + 16);
            acc0[0] = sigmoidf_(acc0[0]) * bf_lo(p0.x); acc0[1] = sigmoidf_(acc0[1]) * bf_hi(p0.x); acc0[2] = sigmoidf_(acc0[2]) * bf_lo(p0.y); acc0[3] = sigmoidf_(acc0[3]) * bf_hi(p0.y);
            acc1[0] = sigmoidf_(acc1[0]) * bf_lo(p1.x); acc1[1] = sigmoidf_(acc1[1]) * bf_hi(p1.x); acc1[2] = sigmoidf_(acc1[2]) * bf_lo(p1.y); acc1[3] = sigmoidf_(acc1[3]) * bf_hi(p1.y);
        }
        u32x2 w0, w1; w0.x = pk_bf16(acc0[0], acc0[1]); w0.y = pk_bf16(acc0[2], acc0[3]); w1.x = pk_bf16(acc1[0], acc1[1]); w1.y = pk_bf16(acc1[2], acc1[3]);
        *(u32x2*)yp = w0; *(u32x2*)(yp + 16) = w1;
        __syncthreads();
    }
}

DI int rowmap(int n, int mode) { return mode == 0 ? n : ((n >> 7) * 256 + (mode == 2 ? 128 : 0) + (n & 127)); }
struct ConvTile { const float* src; bf16_t* dst; const float* gain; int K, N, mode, k0, n0; bool valid; };
DI ConvTile conv_decode(const Params& p, int g) {
    ConvTile c; c.valid = false; c.src = nullptr; c.dst = nullptr; c.gain = nullptr; c.K = 0; c.N = 0; c.mode = 0; c.k0 = 0; c.n0 = 0;
    int base = 0;
#define CJOB(S, D, G, KK, NN, MM) { const int nTn = ((NN) + 255) >> 8, nt = ((KK) >> 6) * nTn; if (g >= base && g < base + nt) { const int t = g - base, tk = t / nTn; \
        c.src = (S); c.dst = (bf16_t*)(p.ws + (D)); c.gain = (G); c.K = (KK); c.N = (NN); c.mode = (MM); c.k0 = tk * 64; c.n0 = (t - tk * nTn) * 256; c.valid = true; } base += nt; }
    CJOB(p.f1_wg, OFF_WGU1, p.f1_pre, 2048, 5632, 1)
    CJOB(p.f1_wu, OFF_WGU1, p.f1_pre, 2048, 5632, 2)
    CJOB(p.w_in, OFF_WIN, p.mix_pre, 2048, NINR, 0)
    CJOB(p.f1_wd, OFF_WD1, nullptr, 5632, 2048, 0)
    CJOB(p.w_out, OFF_WOUT, nullptr, 2048, 2048, 0)
    CJOB(p.w_ple_gate, OFF_WPG, p.ple_pre, 2048, 2048, 0)
    CJOB(p.w_ple_proj, OFF_WPP, nullptr, 256, 2048, 0)
    CJOB(p.f2_wg, OFF_WGU2, p.f2_pre, 2048, 5632, 1)
    CJOB(p.f2_wu, OFF_WGU2, p.f2_pre, 2048, 5632, 2)
    CJOB(p.f2_wd, OFF_WD2, nullptr, 5632, 2048, 0)
#undef CJOB
    return c;
}
constexpr int CT_P0 = 2 * 704 + 928, CT_WD1 = CT_P0 + 704, CT_MISC = CT_WD1 + 256 + 256 + 32, CONV_TILES = CT_MISC + 3 * 704;
DI void conv_load(const ConvTile& c, int tid, f32x4 (&r)[8]) {
    const int n4 = (tid & 63) * 4, kr = (tid >> 6) * 2;
#pragma unroll
    for (int ps = 0; ps < 4; ++ps) {
        const int kk = ps * 16 + kr;
        f32x4 a = {0.f, 0.f, 0.f, 0.f}, b = {0.f, 0.f, 0.f, 0.f};
        if (c.valid && c.n0 + n4 < c.N) { a = __builtin_nontemporal_load((const f32x4*)(c.src + (size_t)(c.k0 + kk) * c.N + c.n0 + n4)); b = __builtin_nontemporal_load((const f32x4*)(c.src + (size_t)(c.k0 + kk + 1) * c.N + c.n0 + n4)); }
        r[2 * ps] = a; r[2 * ps + 1] = b;
    }
}
DI void conv_store(const ConvTile& c, int tid, const f32x4 (&r)[8], unsigned* lds) {
    const int n4 = (tid & 63) * 4, kr = (tid >> 6) * 2;
#pragma unroll
    for (int ps = 0; ps < 4; ++ps) {
        const int kk = ps * 16 + kr;
        f32x4 a = r[2 * ps], b = r[2 * ps + 1];
        if (c.gain) { const float g0 = c.gain[c.k0 + kk], g1 = c.gain[c.k0 + kk + 1]; a *= g0; b *= g1; }
#pragma unroll
        for (int i = 0; i < 4; ++i) lds[(n4 + i) * 33 + (kk >> 1)] = pk_bf16(a[i], b[i]);
    }
    __syncthreads();
#pragma unroll
    for (int q2 = 0; q2 < 4; ++q2) {
        const int q = tid + q2 * 512, n = q >> 3, kc = q & 7;
        u32x4 w; w.x = lds[n * 33 + kc * 4 + 0]; w.y = lds[n * 33 + kc * 4 + 1]; w.z = lds[n * 33 + kc * 4 + 2]; w.w = lds[n * 33 + kc * 4 + 3];
        const int nn = c.n0 + n;
        if (c.mode == 0 || nn < c.N) *(u32x4*)(c.dst + (size_t)rowmap(nn, c.mode) * c.K + c.k0 + kc * 8) = w;
    }
    __syncthreads();
}
DI void conv_phase(const Params& p, unsigned* lds, int t_begin, int t_end, int rank, int nranks) {
    const int tid = otid(), G = nranks;
    int g = t_begin + rank;
    if (g >= t_end) return;
    ConvTile c0 = conv_decode(p, g), c1;
    f32x4 r0[8], r1[8];
    conv_load(c0, tid, r0);
    for (;;) {
        c1 = conv_decode(p, g + G); if (g + G >= t_end) c1.valid = false;
        conv_load(c1, tid, r1);
        conv_store(c0, tid, r0, lds);
        if (!c1.valid) break;
        c0 = conv_decode(p, g + 2 * G); if (g + 2 * G >= t_end) c0.valid = false;
        conv_load(c0, tid, r0);
        conv_store(c1, tid, r1, lds);
        if (!c0.valid) break;
        g += 2 * G;
    }
}

DI void tail_conv(const Params& p, unsigned* lds, int nwg, int t_begin, int t_end) {
    const int G = gridDim.x, rounds = (nwg + G - 1) / G; int idle0 = nwg - (rounds - 1) * G; if (idle0 >= G) idle0 = 0;
    if ((int)blockIdx.x >= idle0) conv_phase(p, lds, t_begin, t_end, (int)blockIdx.x - idle0, G - idle0);
}

DI void row_phase(const Params& p, int which, bool dummy = false) {
    const int tid = otid(), lane = tid & 63, gw = blockIdx.x * 8 + (tid >> 6), nw = gridDim.x * 8;
    const bf16_t* Y = (const bf16_t*)(p.ws + OFF_Y); const bf16_t* H = (const bf16_t*)(p.ws + OFF_H); const float* RINV = (const float*)(p.ws + OFF_RINV);
    bf16_t* Hd = (bf16_t*)(p.ws + (dummy ? OFF_YC : OFF_H)); float* RINVd = (float*)(p.ws + (dummy ? OFF_AB : OFF_RINV));
    const float* gpost = which == 1 ? p.f1_post : which == 2 ? p.mix_post : which == 3 ? p.f2_post : p.ple_post;
    const float scale = (which == 1 || which == 3) ? 0.5f : 1.0f;
    for (int row = gw; row < MT; row += nw) {
        f32x4 x[8];
        if (which <= 1) {
            const float* xs = row < MP ? p.x_prompt + (size_t)row * DM : p.x_sample + (size_t)(row - MP) * DM;
#pragma unroll
            for (int it = 0; it < 8; ++it) x[it] = *(const f32x4*)(xs + (it * 64 + lane) * 4);
        } else {
            const float ri = RINV[row];
#pragma unroll
            for (int it = 0; it < 8; ++it) { const u32x2 hh = *(const u32x2*)(H + (size_t)row * DM + (it * 64 + lane) * 4);
                x[it] = (f32x4){bf_lo(hh.x) * ri, bf_hi(hh.x) * ri, bf_lo(hh.y) * ri, bf_hi(hh.y) * ri}; }
        }
        if (which > 0) {
            f32x4 y[8]; float ss = 0.f;
#pragma unroll
            for (int it = 0; it < 8; ++it) { const u32x2 yy = __builtin_nontemporal_load((const u32x2*)(Y + (size_t)row * DM + (it * 64 + lane) * 4));
                y[it] = (f32x4){bf_lo(yy.x), bf_hi(yy.x), bf_lo(yy.y), bf_hi(yy.y)}; ss += y[it][0] * y[it][0] + y[it][1] * y[it][1] + y[it][2] * y[it][2] + y[it][3] * y[it][3]; }
            ss = wave_sum(ss);
            const float r = rsqrtf(ss * (1.0f / DM) + EPS) * scale;
#pragma unroll
            for (int it = 0; it < 8; ++it) { const f32x4 gp = *(const f32x4*)(gpost + (it * 64 + lane) * 4);
#pragma unroll
                for (int j = 0; j < 4; ++j) x[it][j] += y[it][j] * r * gp[j]; }
        }
        if (which == 4) {
#pragma unroll
            for (int it = 0; it < 8; ++it) __builtin_nontemporal_store(x[it], (f32x4*)(p.out + (size_t)row * DM + (it * 64 + lane) * 4));
        } else {
            float ss = 0.f;
#pragma unroll
            for (int it = 0; it < 8; ++it) ss += x[it][0] * x[it][0] + x[it][1] * x[it][1] + x[it][2] * x[it][2] + x[it][3] * x[it][3];
            ss = wave_sum(ss);
            const float ms = ss * (1.0f / DM) + EPS, r = rsqrtf(ms);
            if (lane == 0) RINVd[row] = ms * r;
#pragma unroll
            for (int it = 0; it < 8; ++it) { u32x2 w; w.x = pk_bf16(x[it][0] * r, x[it][1] * r); w.y = pk_bf16(x[it][2] * r, x[it][3] * r);
                *(u32x2*)(Hd + (size_t)row * DM + (it * 64 + lane) * 4) = w; }
        }
    }
}

DI void mixer_a_phase(const Params& p) {
    const bf16_t* PJ = (const bf16_t*)(p.ws + OFF_BIG); bf16_t* YC = (bf16_t*)(p.ws + OFF_YC);
    const int gt = ((int)blockIdx.x - 32) * 512 + otid(), nthr = ((int)gridDim.x - 32) * 512;
    for (int it = gt; it < MT * 128; it += nthr) {
        const int row = it >> 7, c = (it & 127) * 8;
        int tt, T, s = 0, b = 0;
        if (row < MP) { tt = row & 2047; T = 2048; b = row >> 11; } else { s = (row - MP) >> 2; tt = (row - MP) & 3; T = 4; }
        float u[3][8];
#pragma unroll
        for (int j = 0; j < 3; ++j) {
            const int tp = tt - 2 + j;
            if (tp >= 0) {
                const bf16_t* rp = PJ + (size_t)(row - 2 + j) * NPROJ;
                const u32x4 a = *(const u32x4*)(rp + 1024 + c), h = *(const u32x4*)(rp + 2048 + c);
#pragma unroll
                for (int e = 0; e < 4; ++e) { u[j][2 * e] = bf_lo(a[e]) * bf_lo(h[e]); u[j][2 * e + 1] = bf_hi(a[e]) * bf_hi(h[e]); }
            } else if (row >= MP) {
                const float* sp = p.state_conv_a + ((size_t)s * 2 + (2 + tp)) * 1024 + c;
                const f32x4 a = *(const f32x4*)sp, bq = *(const f32x4*)(sp + 4);
#pragma unroll
                for (int e = 0; e < 4; ++e) { u[j][e] = a[e]; u[j][4 + e] = bq[e]; }
            } else {
#pragma unroll
                for (int e = 0; e < 8; ++e) u[j][e] = 0.f;
            }
        }
        const u32x4 gb = *(const u32x4*)(PJ + (size_t)row * NPROJ + c);
        float y[8];
#pragma unroll
        for (int e = 0; e < 8; ++e) {
            const float w0 = p.conv_a_w[c + e], w1 = p.conv_a_w[1024 + c + e], w2 = p.conv_a_w[2048 + c + e];
            const float g = (e & 1) ? bf_hi(gb[e >> 1]) : bf_lo(gb[e >> 1]);
            y[e] = g * (w0 * u[0][e] + w1 * u[1][e] + w2 * u[2][e]);
        }
        u32x4 w; w.x = pk_bf16(y[0], y[1]); w.y = pk_bf16(y[2], y[3]); w.z = pk_bf16(y[4], y[5]); w.w = pk_bf16(y[6], y[7]);
        *(u32x4*)(YC + (size_t)row * DM + c) = w;
        if (tt >= T - 2) {
            float* op = (row < MP) ? p.out + O_CA_P + ((size_t)b * 2 + (tt - (T - 2))) * 1024 + c : p.out + O_CA_S + ((size_t)s * 2 + (tt - 2)) * 1024 + c;
            *(f32x4*)op = (f32x4){u[2][0], u[2][1], u[2][2], u[2][3]}; *(f32x4*)(op + 4) = (f32x4){u[2][4], u[2][5], u[2][6], u[2][7]};
        }
    }
    for (int it = gt; it < (4 + 128) * 3 * 384; it += nthr) {
        const int c = (it % 384) * 8, rj = it / 384, seq = rj / 3, j = rj % 3;
        const int row = seq < 4 ? seq * 2048 + 2045 + j : MP + (seq - 4) * 4 + 1 + j;
        float* op = seq < 4 ? p.out + O_CQ_P + ((size_t)seq * 3 + j) * 3072 + c : p.out + O_CQ_S + ((size_t)(seq - 4) * 3 + j) * 3072 + c;
        const u32x4 a = *(const u32x4*)(PJ + (size_t)row * NPROJ + 3072 + c);
        *(f32x4*)op = (f32x4){bf_lo(a[0]), bf_hi(a[0]), bf_lo(a[1]), bf_hi(a[1])}; *(f32x4*)(op + 4) = (f32x4){bf_lo(a[2]), bf_hi(a[2]), bf_lo(a[3]), bf_hi(a[3])};
    }
}

DI float softplusf_(float x) { return x > 20.f ? x : log1pf(__expf(x)); }

constexpr int PL_QS = 0, PL_KS = 17408, PL_KT = 34816, PL_VT = 53248, PL_AS = 71680, PL_TF = 88064, PL_TC = 97280, PL_XT = 99840, PL_T1 = 102400, PL_T2 = 111616, PL_SM = 120832;
DI bf16_t f2bf(float x) { return (bf16_t)(pk_bf16(x, 0.f) & 0xffffu); }
DI void prep_phase(const Params& p, unsigned char* lds) {
    int tid = threadIdx.x; asm volatile("" : "+v"(tid));
    const int wid = tid >> 6, lane = tid & 63, fr = lane & 15, fq = lane >> 4;
    bf16_t* qs = (bf16_t*)(lds + PL_QS); bf16_t* ks = (bf16_t*)(lds + PL_KS); bf16_t* kT = (bf16_t*)(lds + PL_KT); bf16_t* vT = (bf16_t*)(lds + PL_VT);
    float* As = (float*)(lds + PL_AS); bf16_t* TF = (bf16_t*)(lds + PL_TF); bf16_t* TC = (bf16_t*)(lds + PL_TC); bf16_t* XT = (bf16_t*)(lds + PL_XT);
    bf16_t* T1 = (bf16_t*)(lds + PL_T1); bf16_t* T2 = (bf16_t*)(lds + PL_T2); float* sm = (float*)(lds + PL_SM);
    const bf16_t* PJ = (const bf16_t*)(p.ws + OFF_BIG); const float* AB = (const float*)(p.ws + OFF_AB);
    for (int item0 = blockIdx.x; item0 < 1024 * (PROBE_DUP == 6 ? 2 : 1); item0 += gridDim.x) {
        const int item = item0 & 1023, bh = item >> 5, n = item & 31, b = bh >> 3, h = bh & 7, t0 = n * 64;
        unsigned char* DI_ = p.ws + OFF_Y + (size_t)item * DITEM;
        {
            const int tl0 = wid * 8, cb = h * 128 + 2 * lane;
            float wq[4][2], wk[4][2], wv[4][2];
#pragma unroll
            for (int j = 0; j < 4; ++j) { const f32x2 a = *(const f32x2*)(p.conv_qkv_w + j * 3072 + cb), bq = *(const f32x2*)(p.conv_qkv_w + j * 3072 + 1024 + cb), c = *(const f32x2*)(p.conv_qkv_w + j * 3072 + 2048 + cb);
                wq[j][0] = a.x; wq[j][1] = a.y; wk[j][0] = bq.x; wk[j][1] = bq.y; wv[j][0] = c.x; wv[j][1] = c.y; }
            const float Aexp = __expf(p.a_log[h]), dtb = p.dt_bias[h];
            unsigned xr[11][3];
#pragma unroll
            for (int i = 0; i < 11; ++i) {
                const int tt = t0 + tl0 - 3 + i; const int ttc = tt < 0 ? 0 : tt; const unsigned msk = tt < 0 ? 0u : 0xffffffffu;
                const bf16_t* rp = PJ + (size_t)(b * 2048 + ttc) * NPROJ + 3072 + cb;
                xr[i][0] = *(const unsigned*)rp & msk; xr[i][1] = *(const unsigned*)(rp + 1024) & msk; xr[i][2] = *(const unsigned*)(rp + 2048) & msk;
            }
            if (lane < 8) {
                const size_t row = (size_t)b * 2048 + t0 + tl0 + lane;
                const float a = AB[row * 16 + h], bb = AB[row * 16 + 8 + h];
                sm[tl0 + lane] = -Aexp * softplusf_(a + dtb); sm[64 + tl0 + lane] = sigmoidf_(bb);
            }
#pragma unroll
            for (int i = 0; i < 8; ++i) {
                float q0 = 0.f, q1 = 0.f, k0 = 0.f, k1 = 0.f, v0 = 0.f, v1 = 0.f;
#pragma unroll
                for (int j = 0; j < 4; ++j) {
                    q0 += wq[j][0] * bf_lo(xr[i + j][0]); q1 += wq[j][1] * bf_hi(xr[i + j][0]);
                    k0 += wk[j][0] * bf_lo(xr[i + j][1]); k1 += wk[j][1] * bf_hi(xr[i + j][1]);
                    v0 += wv[j][0] * bf_lo(xr[i + j][2]); v1 += wv[j][1] * bf_hi(xr[i + j][2]);
                }
                q0 = siluf_(q0); q1 = siluf_(q1); k0 = siluf_(k0); k1 = siluf_(k1); v0 = siluf_(v0); v1 = siluf_(v1);
                const float sq = wave_sum(q0 * q0 + q1 * q1), sk = wave_sum(k0 * k0 + k1 * k1);
                const float rq = rsqrtf(sq + EPS) * 0.08838834764831845f, rk = rsqrtf(sk + EPS);
                const int tl = tl0 + i;
                const unsigned kk = pk_bf16(k0 * rk, k1 * rk), vv = pk_bf16(v0, v1);
                *(unsigned*)(qs + tl * 136 + 2 * lane) = pk_bf16(q0 * rq, q1 * rq);
                *(unsigned*)(ks + tl * 136 + 2 * lane) = kk;
                kT[(2 * lane) * 72 + tl] = (bf16_t)(kk & 0xffffu); kT[(2 * lane + 1) * 72 + tl] = (bf16_t)(kk >> 16);
                vT[(2 * lane) * 72 + tl] = (bf16_t)(vv & 0xffffu); vT[(2 * lane + 1) * 72 + tl] = (bf16_t)(vv >> 16);
            }
        }
        __syncthreads();
        if (tid < 64) {
            float acc = 0.f, mine = 0.f;
            for (int j = 0; j < 64; ++j) { acc += sm[j]; if (j == tid) mine = acc; }
            sm[128 + tid] = mine; sm[192 + tid] = sm[64 + tid] * __expf(mine); sm[256 + tid] = __expf(mine); sm[320 + tid] = __expf(acc - mine);
            if (tid == 63) ((float*)(p.ws + OFF_GAM))[item] = __expf(acc);
        }
        __syncthreads();
        {
            const int ib = wid >> 1;
            bf16_t* QKM = (bf16_t*)(DI_ + D_QKM);
#pragma unroll
            for (int jj2 = 0; jj2 < 2; ++jj2) {
                const int jb = 2 * (wid & 1) + jj2;
                if (jb <= ib) {
                    f32x4 aK = {0.f, 0.f, 0.f, 0.f}, aQ = {0.f, 0.f, 0.f, 0.f};
#pragma unroll
                    for (int kk = 0; kk < 4; ++kk) {
                        const bf16x8 fa_k = *(const bf16x8*)(ks + (ib * 16 + fr) * 136 + kk * 32 + fq * 8);
                        const bf16x8 fa_q = *(const bf16x8*)(qs + (ib * 16 + fr) * 136 + kk * 32 + fq * 8);
                        const bf16x8 fb = *(const bf16x8*)(ks + (jb * 16 + fr) * 136 + kk * 32 + fq * 8);
                        aK = __builtin_amdgcn_mfma_f32_16x16x32_bf16(fa_k, fb, aK, 0, 0, 0);
                        aQ = __builtin_amdgcn_mfma_f32_16x16x32_bf16(fa_q, fb, aQ, 0, 0, 0);
                    }
#pragma unroll
                    for (int jj = 0; jj < 4; ++jj) {
                        const int i = ib * 16 + fq * 4 + jj, j = jb * 16 + fr;
                        const float dec = (i >= j) ? __expf(sm[128 + i] - sm[128 + j]) : 0.f;
                        As[i * 64 + j] = (i > j) ? sm[64 + i] * aK[jj] * dec : 0.f;
                        QKM[i * 64 + j] = f2bf(aQ[jj] * dec);
                    }
                } else {
#pragma unroll
                    for (int jj = 0; jj < 4; ++jj) QKM[(ib * 16 + fq * 4 + jj) * 64 + jb * 16 + fr] = 0;
                }
            }
            {
                const int i = tid >> 3, d0 = (tid & 7) * 16; const float e = sm[256 + i];
                bf16_t* QG = (bf16_t*)(DI_ + D_QG);
#pragma unroll
                for (int hhalf = 0; hhalf < 2; ++hhalf) {
                    const u32x4 v = *(const u32x4*)(qs + i * 136 + d0 + 8 * hhalf);
                    u32x4 w; w.x = pk_bf16(bf_lo(v.x) * e, bf_hi(v.x) * e); w.y = pk_bf16(bf_lo(v.y) * e, bf_hi(v.y) * e); w.z = pk_bf16(bf_lo(v.z) * e, bf_hi(v.z) * e); w.w = pk_bf16(bf_lo(v.w) * e, bf_hi(v.w) * e);
                    *(u32x4*)(QG + i * 128 + d0 + 8 * hhalf) = w;
                }
            }
            {
                const int d = tid >> 2, j0 = (tid & 3) * 16;
                bf16_t* KDT = (bf16_t*)(DI_ + D_KDT);
#pragma unroll
                for (int hhalf = 0; hhalf < 2; ++hhalf) {
                    const int jj0 = j0 + 8 * hhalf;
                    const u32x4 v = *(const u32x4*)(kT + d * 72 + jj0);
                    const f32x4 e0 = *(const f32x4*)(sm + 320 + jj0), e1 = *(const f32x4*)(sm + 320 + jj0 + 4);
                    u32x4 w; w.x = pk_bf16(bf_lo(v.x) * e0[0], bf_hi(v.x) * e0[1]); w.y = pk_bf16(bf_lo(v.y) * e0[2], bf_hi(v.y) * e0[3]); w.z = pk_bf16(bf_lo(v.z) * e1[0], bf_hi(v.z) * e1[1]); w.w = pk_bf16(bf_lo(v.w) * e1[2], bf_hi(v.w) * e1[3]);
                    *(u32x4*)(KDT + d * 64 + jj0) = w;
                }
            }
        }
        __syncthreads();
        if (wid == 0) {
            const int c = lane & 31, hb = lane >> 5;
            const float* Ab = As + (32 * hb) * 64 + 32 * hb;
            float t[32];
#pragma unroll
            for (int i = 0; i < 32; ++i) t[i] = 0.f;
#pragma unroll
            for (int il = 0; il < 32; ++il) {
                float a = (il == c) ? 1.f : 0.f;
#pragma unroll
                for (int j4 = 0; j4 < (il + 3) / 4; ++j4) {
                    const f32x4 av = *(const f32x4*)(Ab + il * 64 + j4 * 4);
#pragma unroll
                    for (int e = 0; e < 4; ++e) if (4 * j4 + e < il) a = __builtin_fmaf(-av[e], t[4 * j4 + e], a);
                }
                asm volatile("" : "+v"(a) :: "memory");
                t[il] = a;
            }
#pragma unroll
            for (int il = 0; il < 32; ++il) { TF[(32 * hb + il) * 72 + 32 * hb + c] = f2bf(t[il]); if (hb == 0) TF[il * 72 + 32 + c] = 0; }
            if (hb == 0) {
#pragma unroll
                for (int i8 = 0; i8 < 4; ++i8) { u32x4 w; w.x = pk_bf16(t[8 * i8], t[8 * i8 + 1]); w.y = pk_bf16(t[8 * i8 + 2], t[8 * i8 + 3]); w.z = pk_bf16(t[8 * i8 + 4], t[8 * i8 + 5]); w.w = pk_bf16(t[8 * i8 + 6], t[8 * i8 + 7]);
                    *(u32x4*)(TC + c * 40 + 8 * i8) = w; }
            }
        }
        __syncthreads();
        if (wid < 4) {
            const int tr = wid >> 1, tc = wid & 1;
            const float* ap = As + (32 + 16 * tr + fr) * 64 + fq * 8;
            const f32x4 a0 = *(const f32x4*)ap, a1 = *(const f32x4*)(ap + 4);
            u32x4 pa; pa.x = pk_bf16(a0[0], a0[1]); pa.y = pk_bf16(a0[2], a0[3]); pa.z = pk_bf16(a1[0], a1[1]); pa.w = pk_bf16(a1[2], a1[3]);
            const bf16x8 fb = *(const bf16x8*)(TC + (16 * tc + fr) * 40 + fq * 8);
            f32x4 x = {0.f, 0.f, 0.f, 0.f};
            x = __builtin_amdgcn_mfma_f32_16x16x32_bf16(__builtin_bit_cast(bf16x8, pa), fb, x, 0, 0, 0);
            u32x2 w; w.x = pk_bf16(x[0], x[1]); w.y = pk_bf16(x[2], x[3]);
            *(u32x2*)(XT + (16 * tc + fr) * 40 + 16 * tr + fq * 4) = w;
        }
        __syncthreads();
        if (wid < 4) {
            const int tr = wid >> 1, tc = wid & 1;
            const bf16x8 fa = *(const bf16x8*)(TF + (32 + 16 * tr + fr) * 72 + 32 + fq * 8);
            const bf16x8 fb = *(const bf16x8*)(XT + (16 * tc + fr) * 40 + fq * 8);
            f32x4 x = {0.f, 0.f, 0.f, 0.f};
            x = __builtin_amdgcn_mfma_f32_16x16x32_bf16(fa, fb, x, 0, 0, 0);
#pragma unroll
            for (int jj = 0; jj < 4; ++jj) TF[(32 + 16 * tr + fq * 4 + jj) * 72 + 16 * tc + fr] = f2bf(-x[jj]);
        }
        __syncthreads();
        {
            const int i = tid >> 3, j0 = (tid & 7) * 8;
            const u32x4 v = *(const u32x4*)(TF + i * 72 + j0);
            const f32x4 s0 = *(const f32x4*)(sm + 192 + j0), s1 = *(const f32x4*)(sm + 192 + j0 + 4), b0 = *(const f32x4*)(sm + 64 + j0), b1 = *(const f32x4*)(sm + 64 + j0 + 4);
            const float tv[8] = {bf_lo(v.x), bf_hi(v.x), bf_lo(v.y), bf_hi(v.y), bf_lo(v.z), bf_hi(v.z), bf_lo(v.w), bf_hi(v.w)};
            u32x4 w1, w2;
            w1.x = pk_bf16(tv[0] * s0[0], tv[1] * s0[1]); w1.y = pk_bf16(tv[2] * s0[2], tv[3] * s0[3]); w1.z = pk_bf16(tv[4] * s1[0], tv[5] * s1[1]); w1.w = pk_bf16(tv[6] * s1[2], tv[7] * s1[3]);
            w2.x = pk_bf16(tv[0] * b0[0], tv[1] * b0[1]); w2.y = pk_bf16(tv[2] * b0[2], tv[3] * b0[3]); w2.z = pk_bf16(tv[4] * b1[0], tv[5] * b1[1]); w2.w = pk_bf16(tv[6] * b1[2], tv[7] * b1[3]);
            *(u32x4*)(T1 + i * 72 + j0) = w1; *(u32x4*)(T2 + i * 72 + j0) = w2;
        }
        __syncthreads();
        {
            bf16_t* W = (bf16_t*)(DI_ + D_W); bf16_t* UT = (bf16_t*)(DI_ + D_UT);
            bf16x8 fk[2], fv[2];
#pragma unroll
            for (int kk = 0; kk < 2; ++kk) { fk[kk] = *(const bf16x8*)(kT + (16 * wid + fr) * 72 + kk * 32 + fq * 8); fv[kk] = *(const bf16x8*)(vT + (16 * wid + fr) * 72 + kk * 32 + fq * 8); }
#pragma unroll
            for (int it = 0; it < 4; ++it) {
                f32x4 aw = {0.f, 0.f, 0.f, 0.f}, au = {0.f, 0.f, 0.f, 0.f};
#pragma unroll
                for (int kk = 0; kk < 2; ++kk) {
                    const bf16x8 f1 = *(const bf16x8*)(T1 + (16 * it + fr) * 72 + kk * 32 + fq * 8);
                    const bf16x8 f2 = *(const bf16x8*)(T2 + (16 * it + fr) * 72 + kk * 32 + fq * 8);
                    aw = __builtin_amdgcn_mfma_f32_16x16x32_bf16(fk[kk], f1, aw, 0, 0, 0);
                    au = __builtin_amdgcn_mfma_f32_16x16x32_bf16(f2, fv[kk], au, 0, 0, 0);
                }
                u32x2 ww; ww.x = pk_bf16(aw[0], aw[1]); ww.y = pk_bf16(aw[2], aw[3]);
                *(u32x2*)(W + (16 * it + fr) * 128 + 16 * wid + 4 * fq) = ww;
                u32x2 wu; wu.x = pk_bf16(au[0], au[1]); wu.y = pk_bf16(au[2], au[3]);
                *(u32x2*)(UT + (16 * wid + fr) * 64 + 16 * it + 4 * fq) = wu;
            }
        }
        __syncthreads();
    }
}

constexpr int SC_W = 0, SC_QG = 16896, SC_KDT = 33792, SC_QKM = 51200, SC_UT = 59904, SC_BUF = 77312;
DI void scan_fetch(const unsigned char* src, int t, u32x4 (&r)[9]) {
#pragma unroll
    for (int i = 0; i < 9; ++i) r[i] = __builtin_nontemporal_load((const u32x4*)(src + (size_t)(t + i * 512) * 16));
}
DI void scan_put(unsigned char* buf, int t, const u32x4 (&r)[9]) {
#pragma unroll
    for (int i = 0; i < 9; ++i) {
        const int q = t + i * 512;
        int off;
        if (i < 2) { off = SC_W + (q >> 4) * 264 + (q & 15) * 16; }
        else if (i < 4) { const int qq = q - 1024; off = SC_QG + (qq >> 4) * 264 + (qq & 15) * 16; }
        else if (i < 6) { const int qq = q - 2048; off = SC_KDT + (qq >> 3) * 136 + (qq & 7) * 16; }
        else if (i < 7) { const int qq = q - 3072; off = SC_QKM + (qq >> 3) * 136 + (qq & 7) * 16; }
        else { const int qq = q - 3584; off = SC_UT + (qq >> 3) * 136 + (qq & 7) * 16; }
        *(u32x2*)(buf + off) = (u32x2){r[i].x, r[i].y}; *(u32x2*)(buf + off + 8) = (u32x2){r[i].z, r[i].w};
    }
}
DI bf16x8 lda8(const unsigned char* base, int row, int col, int stride) {
    const s16x4 lo = *(const s16x4*)(base + row * stride + col * 2), hi = *(const s16x4*)(base + row * stride + col * 2 + 16);
    return __builtin_shufflevector(lo, hi, 0, 1, 2, 3, 4, 5, 6, 7);
}
DI bf16x8 pack8(const f32x16& x, int s) {
    u32x4 pk; pk.x = pk_bf16(x[8 * s], x[8 * s + 1]); pk.y = pk_bf16(x[8 * s + 2], x[8 * s + 3]); pk.z = pk_bf16(x[8 * s + 4], x[8 * s + 5]); pk.w = pk_bf16(x[8 * s + 6], x[8 * s + 7]);
    return __builtin_bit_cast(bf16x8, pk);
}
#define MFMA32(a, b, c) __builtin_amdgcn_mfma_f32_32x32x16_bf16((a), (b), (c), 0, 0, 0)
DI void scan_phase(const Params& p, unsigned char* lds) {
    int tid = threadIdx.x; asm volatile("" : "+v"(tid));
    const int wid = tid >> 6, lane = tid & 63, r = lane & 31, hh = lane >> 5;
    const int bh = blockIdx.x, b = bh >> 3, h = bh & 7, c0 = (wid & 3) * 32;
    const unsigned char* items = p.ws + OFF_Y + (size_t)bh * 32 * DITEM;
    const float* GAM = (const float*)(p.ws + OFF_GAM) + bh * 32;
    float* ORAW = (float*)(p.ws + OFF_ORAW);
    f32x16 Sacc[4];
#pragma unroll
    for (int d = 0; d < 4; ++d)
#pragma unroll
        for (int i = 0; i < 16; ++i) Sacc[d][i] = 0.f;
    u32x4 ra[9];
    scan_fetch(items, tid, ra); scan_put(lds, tid, ra); scan_fetch(items + DITEM, tid, ra);
    __syncthreads();
    for (int n = 0; n < 32; ++n) {
        const unsigned char* buf = lds + (n & 1) * SC_BUF;
        if (n + 1 < 32) scan_put(lds + ((n + 1) & 1) * SC_BUF, tid, ra);
        if (n + 2 < 32) scan_fetch(items + (size_t)(n + 2) * DITEM, tid, ra);
        if (wid < 4) {
            const float gam = GAM[n];
            bf16x8 Sb[4][2];
#pragma unroll
            for (int d = 0; d < 4; ++d) { Sb[d][0] = pack8(Sacc[d], 0); Sb[d][1] = pack8(Sacc[d], 1); }
            bf16x8 Vb[2][2];
#pragma unroll
            for (int mb = 0; mb < 2; ++mb) {
                f32x16 t;
#pragma unroll
                for (int i = 0; i < 16; ++i) t[i] = 0.f;
#pragma unroll
                for (int d = 0; d < 4; ++d)
#pragma unroll
                    for (int s = 0; s < 2; ++s) t = MFMA32(lda8(buf + SC_W, 32 * mb + r, 32 * d + 16 * s + 4 * hh, 264), Sb[d][s], t);
                f32x16 vn;
#pragma unroll
                for (int g = 0; g < 4; ++g) {
                    const u32x2 uu = *(const u32x2*)(buf + SC_UT + (c0 + r) * 136 + (32 * mb + 8 * g + 4 * hh) * 2);
                    vn[4 * g] = bf_lo(uu.x) - t[4 * g]; vn[4 * g + 1] = bf_hi(uu.x) - t[4 * g + 1]; vn[4 * g + 2] = bf_lo(uu.y) - t[4 * g + 2]; vn[4 * g + 3] = bf_hi(uu.y) - t[4 * g + 3];
                }
                Vb[mb][0] = pack8(vn, 0); Vb[mb][1] = pack8(vn, 1);
            }
#pragma unroll
            for (int mb = 0; mb < 2; ++mb) {
                f32x16 o;
#pragma unroll
                for (int i = 0; i < 16; ++i) o[i] = 0.f;
#pragma unroll
                for (int d = 0; d < 4; ++d)
#pragma unroll
                    for (int s = 0; s < 2; ++s) o = MFMA32(lda8(buf + SC_QG, 32 * mb + r, 32 * d + 16 * s + 4 * hh, 264), Sb[d][s], o);
#pragma unroll
                for (int jb = 0; jb <= mb; ++jb)
#pragma unroll
                    for (int s = 0; s < 2; ++s) o = MFMA32(lda8(buf + SC_QKM, 32 * mb + r, 32 * jb + 16 * s + 4 * hh, 136), Vb[jb][s], o);
                float* op = ORAW + ((size_t)b * 2048 + n * 64 + 32 * mb + 4 * hh) * 1024 + h * 128 + c0 + r;
#pragma unroll
                for (int i = 0; i < 16; ++i) op[(size_t)((i & 3) + 8 * (i >> 2)) * 1024] = o[i];
            }
#pragma unroll
            for (int d = 0; d < 4; ++d) {
#pragma unroll
                for (int i = 0; i < 16; ++i) Sacc[d][i] *= gam;
#pragma unroll
                for (int jb = 0; jb < 2; ++jb)
#pragma unroll
                    for (int s = 0; s < 2; ++s) Sacc[d] = MFMA32(lda8(buf + SC_KDT, 32 * d + r, 32 * jb + 16 * s + 4 * hh, 136), Vb[jb][s], Sacc[d]);
            }
        }
        __syncthreads();
    }
    if (wid < 4) {
        float* sp = p.out + O_S_P + ((size_t)bh * 128 + 4 * hh) * 128 + c0 + r;
#pragma unroll
        for (int d = 0; d < 4; ++d)
#pragma unroll
            for (int i = 0; i < 16; ++i) __builtin_nontemporal_store(Sacc[d][i], sp + (size_t)(32 * d + (i & 3) + 8 * (i >> 2)) * 128);
    }
}

DI void sample_phase(const Params& p, unsigned char* lds, int first, int stride) {
    int tid = threadIdx.x; asm volatile("" : "+v"(tid));
    const int wid = tid >> 6, lane = tid & 63;
    float* qS = (float*)lds; float* kS = qS + 1024; float* vS = kS + 1024; float* gS = vS + 1024; float* bS = gS + 8;
    float* red = (float*)(lds + 16384);
    float* ored = (float*)(lds + 32768);
    const bf16_t* PJ = (const bf16_t*)(p.ws + OFF_BIG); const float* AB = (const float*)(p.ws + OFF_AB);
    float* ORAW = (float*)(p.ws + OFF_ORAW);
    const int hl = wid >> 2, tok = wid & 3, cs = wid & 3, c4 = lane & 31, dh = lane >> 5;
    for (int item = first; item < 512; item += stride) {
        const int s = item >> 2, hp = item & 3, h = 2 * hp + hl, cb = h * 128 + 2 * lane;
        f32x2 hv[4][3]; unsigned pv[4][3]; f32x2 wv[4][3];
#pragma unroll
        for (int j = 0; j < 4; ++j) {
            const int idx = tok + j; const bool hist = idx < 3;
            const float* sp = p.state_conv_qkv + ((size_t)s * 3 + (hist ? idx : 0)) * 3072 + cb;
            const bf16_t* rp = PJ + (size_t)(MP + s * 4 + (hist ? 0 : idx - 3)) * NPROJ + 3072 + cb;
#pragma unroll
            for (int sg = 0; sg < 3; ++sg) { hv[j][sg] = *(const f32x2*)(sp + sg * 1024); pv[j][sg] = *(const unsigned*)(rp + sg * 1024); wv[j][sg] = *(const f32x2*)(p.conv_qkv_w + j * 3072 + sg * 1024 + cb); }
        }
        const size_t abrow = (size_t)MP + s * 4 + tok;
        const float ab_a = AB[abrow * 16 + h], ab_b = AB[abrow * 16 + 8 + h], alog = p.a_log[h], dtb = p.dt_bias[h];
        const float* Sin = p.state_delta + ((size_t)(s * 8 + h) * 128 + 32 * cs + 16 * dh) * 128 + 4 * c4;
        f32x4 S[16];
#pragma unroll
        for (int i = 0; i < 16; ++i) S[i] = __builtin_nontemporal_load((const f32x4*)(Sin + (size_t)i * 128));
        asm volatile("" ::: "memory");
        {
            float y[3][2];
#pragma unroll
            for (int sg = 0; sg < 3; ++sg) { float a0 = 0.f, a1 = 0.f;
#pragma unroll
                for (int j = 0; j < 4; ++j) { const bool hist = (tok + j) < 3; const float x0 = hist ? hv[j][sg].x : bf_lo(pv[j][sg]), x1 = hist ? hv[j][sg].y : bf_hi(pv[j][sg]);
                    a0 += wv[j][sg].x * x0; a1 += wv[j][sg].y * x1; }
                y[sg][0] = siluf_(a0); y[sg][1] = siluf_(a1); }
            const float sq = wave_sum(y[0][0] * y[0][0] + y[0][1] * y[0][1]), sk = wave_sum(y[1][0] * y[1][0] + y[1][1] * y[1][1]);
            const float rq = rsqrtf(sq + EPS) * 0.08838834764831845f, rk = rsqrtf(sk + EPS);
            const int o = (hl * 4 + tok) * 128 + 2 * lane;
            *(f32x2*)(qS + o) = (f32x2){y[0][0] * rq, y[0][1] * rq}; *(f32x2*)(kS + o) = (f32x2){y[1][0] * rk, y[1][1] * rk}; *(f32x2*)(vS + o) = (f32x2){y[2][0], y[2][1]};
            if (lane == 0) { gS[hl * 4 + tok] = -__expf(alog) * softplusf_(ab_a + dtb); bS[hl * 4 + tok] = sigmoidf_(ab_b); }
        }
        __syncthreads();
#pragma unroll
        for (int tk = 0; tk < 4; ++tk) {
            const float eg = __expf(gS[hl * 4 + tk]), bt = bS[hl * 4 + tk];
            const float* kp = kS + (hl * 4 + tk) * 128 + 32 * cs + 16 * dh; const float* qp = qS + (hl * 4 + tk) * 128 + 32 * cs + 16 * dh;
            f32x4 kv[4];
#pragma unroll
            for (int i4 = 0; i4 < 4; ++i4) kv[i4] = *(const f32x4*)(kp + 4 * i4);
            f32x4 rp = {0.f, 0.f, 0.f, 0.f};
#pragma unroll
            for (int i = 0; i < 16; ++i) rp += S[i] * kv[i >> 2][i & 3];
#pragma unroll
            for (int j = 0; j < 4; ++j) rp[j] += __shfl_xor(rp[j], 32);
            float* rb = red + ((tk * 2 + hl) * 4) * 128;
            if (dh == 0) *(f32x4*)(rb + cs * 128 + 4 * c4) = rp;
            __syncthreads();
            const f32x4 rr = (*(const f32x4*)(rb + 4 * c4) + *(const f32x4*)(rb + 128 + 4 * c4)) + (*(const f32x4*)(rb + 256 + 4 * c4) + *(const f32x4*)(rb + 384 + 4 * c4));
            const f32x4 vv = *(const f32x4*)(vS + (hl * 4 + tk) * 128 + 4 * c4);
            f32x4 vn;
#pragma unroll
            for (int j = 0; j < 4; ++j) vn[j] = bt * (vv[j] - eg * rr[j]);
            f32x4 qv[4];
#pragma unroll
            for (int i4 = 0; i4 < 4; ++i4) qv[i4] = *(const f32x4*)(qp + 4 * i4);
            f32x4 op = {0.f, 0.f, 0.f, 0.f};
#pragma unroll
            for (int i = 0; i < 16; ++i) { S[i] = S[i] * eg + vn * kv[i >> 2][i & 3]; op += S[i] * qv[i >> 2][i & 3]; }
#pragma unroll
            for (int j = 0; j < 4; ++j) op[j] += __shfl_xor(op[j], 32);
            if (dh == 0) *(f32x4*)(ored + ((tk * 2 + hl) * 4 + cs) * 128 + 4 * c4) = op;
        }
        float* Sout = p.out + O_S_S + ((size_t)(s * 8 + h) * 128 + 32 * cs + 16 * dh) * 128 + 4 * c4;
#pragma unroll
        for (int i = 0; i < 16; ++i) __builtin_nontemporal_store(S[i], (f32x4*)(Sout + (size_t)i * 128));
        __syncthreads();
        {
            const int o0 = tid * 2, tkk = o0 >> 8, hh2 = (o0 >> 7) & 1, cc = o0 & 127;
            const float* ob = ored + ((tkk * 2 + hh2) * 4) * 128 + cc;
            const f32x2 v = (*(const f32x2*)ob + *(const f32x2*)(ob + 128)) + (*(const f32x2*)(ob + 256) + *(const f32x2*)(ob + 384));
            *(f32x2*)(ORAW + ((size_t)MP + s * 4 + tkk) * 1024 + (2 * hp + hh2) * 128 + cc) = v;
        }
        __syncthreads();
    }
}

DI void gated_norm_phase(const Params& p) {
    const int tid = otid(), lane = tid & 63, gw = blockIdx.x * 8 + (tid >> 6), nw = gridDim.x * 8;
    const float* ORAW = (const float*)(p.ws + OFF_ORAW); const bf16_t* PJ = (const bf16_t*)(p.ws + OFF_BIG); bf16_t* YC = (bf16_t*)(p.ws + OFF_YC);
    for (int row = gw; row < MT; row += nw) {
        f32x4 o[4]; float ss = 0.f;
#pragma unroll
        for (int i = 0; i < 4; ++i) { o[i] = __builtin_nontemporal_load((const f32x4*)(ORAW + (size_t)row * 1024 + 16 * lane + 4 * i)); ss += o[i][0] * o[i][0] + o[i][1] * o[i][1] + o[i][2] * o[i][2] + o[i][3] * o[i][3]; }
        ss += __shfl_xor(ss, 1); ss += __shfl_xor(ss, 2); ss += __shfl_xor(ss, 4);
        const float rr = rsqrtf(ss * (1.0f / 128.0f) + EPS);
        const u32x4 z0 = *(const u32x4*)(PJ + (size_t)row * NPROJ + 6144 + 16 * lane), z1 = *(const u32x4*)(PJ + (size_t)row * NPROJ + 6144 + 16 * lane + 8);
        float y[16];
#pragma unroll
        for (int e = 0; e < 16; ++e) {
            const unsigned zz = e < 8 ? z0[e >> 1] : z1[(e - 8) >> 1];
            const float z = (e & 1) ? bf_hi(zz) : bf_lo(zz);
            y[e] = o[e >> 2][e & 3] * rr * p.dn_norm[(16 * lane + e) & 127] * siluf_(z);
        }
        u32x4 w0, w1; w0.x = pk_bf16(y[0], y[1]); w0.y = pk_bf16(y[2], y[3]); w0.z = pk_bf16(y[4], y[5]); w0.w = pk_bf16(y[6], y[7]);
        w1.x = pk_bf16(y[8], y[9]); w1.y = pk_bf16(y[10], y[11]); w1.z = pk_bf16(y[12], y[13]); w1.w = pk_bf16(y[14], y[15]);
        *(u32x4*)(YC + (size_t)row * DM + 1024 + 16 * lane) = w0; *(u32x4*)(YC + (size_t)row * DM + 1024 + 16 * lane + 8) = w1;
    }
}

#define XB_TMO      128
#define XB_XCNT(j)  (256  + 64 * (j))
#define XB_XSUB(j)  (1280 + 64 * (j))
#define XB_XGEN(j)  (2304 + 64 * (j))
#define XB_TOP      3328
#define XB_TOPGEN   3392
#define XCD_BAR_WORDS 3456
#define XB_SPIN_CAP (1u << 22)
DI unsigned xb_ld(unsigned* p)              { return __hip_atomic_load(p, __ATOMIC_RELAXED, __HIP_MEMORY_SCOPE_AGENT); }
DI unsigned xb_add(unsigned* p, unsigned v) { return __hip_atomic_fetch_add(p, v, __ATOMIC_RELAXED, __HIP_MEMORY_SCOPE_AGENT); }
DI unsigned xb_xcc_id() { return (unsigned)__builtin_amdgcn_s_getreg((3 << 11) | 20) & 0xFu; }
#define XB_SPIN(cond, bar) do { unsigned _sp = 0; while (cond) { __builtin_amdgcn_s_sleep(1); \
    if ((++_sp & 255u) == 0u) { if (xb_ld(&(bar)[XB_TMO])) break; if (_sp > XB_SPIN_CAP) { atomicAdd(&(bar)[XB_TMO], 1u); break; } } } } while (0)
struct XcdBarrier { unsigned* bar; unsigned x; volatile LAS unsigned* st; };
DI XcdBarrier xcd_barrier_post(unsigned* bar, volatile LAS unsigned* st) {
    XcdBarrier b; b.bar = bar; b.x = xb_xcc_id(); b.st = st;
    if (threadIdx.x == 0) (void)xb_add(&bar[XB_XCNT(b.x)], 1u);
    return b;
}
DI void xcd_barrier_complete(unsigned* bar, unsigned x, unsigned& nloc, unsigned& nx) {
    const unsigned G = gridDim.x * gridDim.y * gridDim.z;
    unsigned sum, cnt, mine, sp = 0u;
    for (;;) {
        sum = 0u; cnt = 0u; mine = 0u;
#pragma unroll
        for (unsigned j = 0; j < 16; ++j) { const unsigned c = xb_ld(&bar[XB_XCNT(j)]); sum += c; cnt += (c > 0u) ? 1u : 0u; mine = (j == x) ? c : mine; }
        if (sum == G) break;
        __builtin_amdgcn_s_sleep(1);
        if ((++sp & 255u) == 0u) { if (xb_ld(&bar[XB_TMO])) break; if (sp > XB_SPIN_CAP) { atomicAdd(&bar[XB_TMO], 1u); break; } }
    }
    nloc = mine > 0u ? mine : 1u; nx = cnt > 0u ? cnt : 1u;
}
DI void xcd_barrier(const XcdBarrier& b) {
    asm volatile("s_waitcnt vmcnt(0)" ::: "memory");
    __syncthreads();
    if (threadIdx.x == 0) {
        unsigned* bar = b.bar;
        __builtin_amdgcn_s_waitcnt(0);
        unsigned nloc = b.st[0], nx = b.st[1];
        if (nloc == 0u) { xcd_barrier_complete(bar, b.x, nloc, nx); b.st[0] = nloc; b.st[1] = nx; }
        const unsigned old = xb_add(&bar[XB_XSUB(b.x)], 1u);
        const unsigned gen = old / nloc;
        if (old + 1u == (gen + 1u) * nloc) {
            __builtin_amdgcn_fence(__ATOMIC_RELEASE, "agent");
            asm volatile("s_waitcnt vmcnt(0)" ::: "memory");
            const unsigned og = xb_add(&bar[XB_TOP], 1u);
            const unsigned tg = og / nx;
            if (og + 1u == (tg + 1u) * nx) xb_add(&bar[XB_TOPGEN], 1u);
            else XB_SPIN(xb_ld(&bar[XB_TOPGEN]) == tg, bar);
            __builtin_amdgcn_fence(__ATOMIC_ACQUIRE, "agent");
            xb_add(&bar[XB_XGEN(b.x)], 1u);
            asm volatile("s_waitcnt vmcnt(0)" ::: "memory");
        } else {
            XB_SPIN(xb_ld(&bar[XB_XGEN(b.x)]) == gen, bar);
            __builtin_amdgcn_fence(__ATOMIC_ACQUIRE, "agent");
            asm volatile("s_waitcnt vmcnt(0)" ::: "memory");
        }
    }
    __syncthreads();
}

__global__ void __launch_bounds__(512, 2) fwd_megakernel(Params p) {
    extern __shared__ __attribute__((aligned(16))) unsigned char shm[];
    cg::grid_group grid = cg::this_grid();
    LAS unsigned char* lds = (LAS unsigned char*)shm;
    unsigned char* ws = p.ws;
    if (threadIdx.x == 0) { *(volatile LAS unsigned*)(lds + LDS_MAIN) = 0u; *(volatile LAS unsigned*)(lds + LDS_MAIN + 4) = 0u; }
    __syncthreads();
    if (blockIdx.x == 0) { unsigned* bw = (unsigned*)(ws + OFF_BAR); for (int i = threadIdx.x; i < XCD_BAR_WORDS; i += 512) __hip_atomic_store(bw + i, 0u, __ATOMIC_RELAXED, __HIP_MEMORY_SCOPE_AGENT); }
    grid.sync();
    const XcdBarrier xb = xcd_barrier_post((unsigned*)(ws + OFF_BAR), (volatile LAS unsigned*)(lds + LDS_MAIN));
    bf16_t* H = (bf16_t*)(ws + OFF_H); bf16_t* YC = (bf16_t*)(ws + OFF_YC); bf16_t* BIG = (bf16_t*)(ws + OFF_BIG); bf16_t* Y = (bf16_t*)(ws + OFF_Y);
    DUP(1) {
        conv_phase(p, (unsigned*)shm, 0, CT_P0, (int)blockIdx.x, (int)gridDim.x);
        bf16_t* PBF = (bf16_t*)(ws + OFF_PBF);
        for (int it = blockIdx.x * 512 + otid(); it < MT * DPLE / 4; it += gridDim.x * 512) {
            const int e = it * 4; const float* sp = e < MP * DPLE ? p.p_prompt + e : p.p_sample + (e - MP * DPLE);
            const f32x4 v = __builtin_nontemporal_load((const f32x4*)sp); u32x2 w; w.x = pk_bf16(v[0], v[1]); w.y = pk_bf16(v[2], v[3]); *(u32x2*)(PBF + e) = w;
        }
        row_phase(p, 0);
    }
    xcd_barrier(xb);
    DUP(2) run_gemm(lds, H, (const bf16_t*)(ws + OFF_WGU1), MT, 11264, 2048, pg8::EpiSwiglu{BIG});
    tail_conv(p, (unsigned*)shm, 34 * 44, CT_P0, CT_WD1);
    xcd_barrier(xb);
    DUP(3) run_gemm(lds, BIG, (const bf16_t*)(ws + OFF_WD1), MP, 2048, 5632, pg8::EpiY{Y, DM});
    DUP(4) small_gemm<0>(shm, BIG + (size_t)MP * FF, (const bf16_t*)(ws + OFF_WD1), 5632, Y + (size_t)MP * DM);
    xcd_barrier(xb);
    row_phase(p, 1);
    xcd_barrier(xb);
    DUP(5) run_gemm(lds, H, (const bf16_t*)(ws + OFF_WIN), MT, NINP, 2048, pg8::EpiProj{BIG, (float*)(ws + OFF_AB)});
    xcd_barrier(xb);
    prep_phase(p, shm);
    xcd_barrier(xb);
    DUP(8) { if (blockIdx.x < 32) scan_phase(p, shm); else { sample_phase(p, shm, (int)blockIdx.x - 32, (int)gridDim.x - 32); mixer_a_phase(p);
             conv_phase(p, (unsigned*)shm, CT_WD1, CONV_TILES, (int)blockIdx.x - 32, (int)gridDim.x - 32); } }
    XDUP(9) { if (blockIdx.x < 32) scan_phase(p, shm); }
    XDUP(15) { if (blockIdx.x >= 32) sample_phase(p, shm, (int)blockIdx.x - 32, (int)gridDim.x - 32); }
    XDUP(16) { if (blockIdx.x >= 32) mixer_a_phase(p); }
    xcd_barrier(xb);
    DUP(10) gated_norm_phase(p);
    XDUP(11) { xcd_barrier(xb); xcd_barrier(xb); xcd_barrier(xb); xcd_barrier(xb); xcd_barrier(xb); }
    xcd_barrier(xb);
    run_gemm(lds, YC, (const bf16_t*)(ws + OFF_WOUT), MP, 2048, 2048, pg8::EpiY{Y, DM});
    small_gemm<0>(shm, YC + (size_t)MP * DM, (const bf16_t*)(ws + OFF_WOUT), 2048, Y + (size_t)MP * DM);
    xcd_barrier(xb);
    row_phase(p, 2);
    XDUP(13) { xcd_barrier(xb); row_phase(p, 2, true); row_phase(p, 2, true); }
    xcd_barrier(xb);
    run_gemm(lds, H, (const bf16_t*)(ws + OFF_WGU2), MT, 11264, 2048, pg8::EpiSwiglu{BIG});
    xcd_barrier(xb);
    run_gemm(lds, BIG, (const bf16_t*)(ws + OFF_WD2), MP, 2048, 5632, pg8::EpiY{Y, DM});
    small_gemm<0>(shm, BIG + (size_t)MP * FF, (const bf16_t*)(ws + OFF_WD2), 5632, Y + (size_t)MP * DM);
    xcd_barrier(xb);
    row_phase(p, 3);
    xcd_barrier(xb);
    run_gemm(lds, (const bf16_t*)(ws + OFF_PBF), (const bf16_t*)(ws + OFF_WPP), MP, 2048, 256, pg8::EpiY{Y, DM});
    run_gemm(lds, H, (const bf16_t*)(ws + OFF_WPG), MP, 2048, 2048, pg8::EpiGate{Y, DM});
    small_gemm<0>(shm, (const bf16_t*)(ws + OFF_PBF) + (size_t)MP * DPLE, (const bf16_t*)(ws + OFF_WPP), 256, Y + (size_t)MP * DM);
    small_gemm<1>(shm, H + (size_t)MP * DM, (const bf16_t*)(ws + OFF_WPG), 2048, Y + (size_t)MP * DM);
    xcd_barrier(xb);
    row_phase(p, 4);
}

extern "C" void kernel_launch(void* const* d_in, const int* in_sizes, int n_in, void* d_out, int out_size, void* d_ws, size_t ws_size, hipStream_t stream) {
    static int grid_blocks = 0;
    if (grid_blocks == 0) {
        if (n_in != 30 || ws_size < WS_END || out_size != 36614144) { fprintf(stderr, "kernel_launch: unexpected shapes (n_in %d, ws %zu need %zu, out %d)\n", n_in, ws_size, (size_t)WS_END, out_size); grid_blocks = -1; return; }
        int dev = 0, cus = 0, per_cu = 0;
        hipGetDevice(&dev);
        hipDeviceGetAttribute(&cus, hipDeviceAttributeMultiprocessorCount, dev);
        if (hipFuncSetAttribute((const void*)fwd_megakernel, hipFuncAttributeMaxDynamicSharedMemorySize, LDS_BYTES) != hipSuccess) { fprintf(stderr, "kernel_launch: hipFuncSetAttribute failed\n"); grid_blocks = -1; return; }
        hipOccupancyMaxActiveBlocksPerMultiprocessor(&per_cu, (const void*)fwd_megakernel, 512, LDS_BYTES);
        if (per_cu < 1) { fprintf(stderr, "kernel_launch: occupancy query says %d blocks/CU\n", per_cu); per_cu = 1; }
        if (cus < 256) { fprintf(stderr, "kernel_launch: built for a 256-CU device, found %d CUs; nothing launched\n", cus); grid_blocks = -1; return; }
        grid_blocks = 256;
    }
    if (grid_blocks < 0) return;
    Params p{};
    const float** pp = (const float**)&p;
    for (int i = 0; i < 30; ++i) pp[i] = (const float*)d_in[i];
    p.out = (float*)d_out; p.ws = (unsigned char*)d_ws;
    void* args[] = {&p};
    hipError_t e = hipLaunchCooperativeKernel((const void*)fwd_megakernel, dim3(grid_blocks), dim3(512), args, LDS_BYTES, stream);
    if (e != hipSuccess) fprintf(stderr, "cooperative launch failed: %s (grid %d)\n", hipGetErrorString(e), grid_blocks);
}
```

```cpp
#include <hip/hip_runtime.h>
#include <hip/hip_cooperative_groups.h>
#include <cstdio>
namespace cg = cooperative_groups;

#define LAS __attribute__((address_space(3)))
#define DI __device__ __forceinline__
typedef unsigned short bf16_t;
typedef short bf16x8 __attribute__((ext_vector_type(8)));
typedef short s16x4 __attribute__((ext_vector_type(4)));
typedef float f32x2 __attribute__((ext_vector_type(2)));
typedef float f32x4 __attribute__((ext_vector_type(4)));
typedef float f32x16 __attribute__((ext_vector_type(16)));
typedef unsigned u32x2 __attribute__((ext_vector_type(2)));
typedef unsigned u32x4 __attribute__((ext_vector_type(4)));
typedef __bf16 bf16v2 __attribute__((ext_vector_type(2)));

constexpr int MP = 8192, MS = 512, MT = 8704, DM = 2048, FF = 5632, NPROJ = 7168, NINP = 7424, NINR = 7184, DPLE = 256;
constexpr float EPS = 1e-6f;
constexpr size_t O_Y = 0, O_CA_P = 17825792, O_CQ_P = 17833984, O_S_P = 17870848, O_CA_S = 18395136, O_CQ_S = 18657280, O_S_S = 19836928;
constexpr size_t SZ_WGU = 11264ull * 2048 * 2, SZ_WD = 2048ull * 5632 * 2, SZ_WIN = 7424ull * 2048 * 2, SZ_W2K = 2048ull * 2048 * 2, SZ_WPP = 2048ull * 256 * 2;
constexpr size_t OFF_WGU1 = 0, OFF_WD1 = OFF_WGU1 + SZ_WGU, OFF_WIN = OFF_WD1 + SZ_WD, OFF_WOUT = OFF_WIN + SZ_WIN, OFF_WGU2 = OFF_WOUT + SZ_W2K,
                 OFF_WD2 = OFF_WGU2 + SZ_WGU, OFF_WPG = OFF_WD2 + SZ_WD, OFF_WPP = OFF_WPG + SZ_W2K, OFF_H = OFF_WPP + SZ_WPP,
                 OFF_YC = OFF_H + 35651584ull, OFF_PBF = OFF_YC + 35651584ull, OFF_BIG = OFF_PBF + 4456448ull, OFF_Y = OFF_BIG + 124780544ull,
                 OFF_AB = OFF_Y + 75501568ull, OFF_BAR = OFF_AB + 557056ull, OFF_ORAW = OFF_BAR + 16384ull, OFF_RINV = OFF_ORAW + 35651584ull, WS_END = OFF_RINV + 36864ull;
constexpr size_t DITEM = 73728, D_W = 0, D_QG = 16384, D_KDT = 32768, D_QKM = 49152, D_UT = 57344, OFF_GAM = OFF_Y + 1024ull * DITEM;
constexpr int LDS_MAIN = 154624, LDS_BYTES = LDS_MAIN + 16;
#ifndef PROBE_DUP
#define PROBE_DUP 0
#endif
#define DUP(n) for (int _d = 0; _d < ((PROBE_DUP == (n)) ? 2 : 1); ++_d)
#define XDUP(n) for (int _d = 0; _d < ((PROBE_DUP == (n)) ? 1 : 0); ++_d)

struct Params {
    const float *x_prompt, *x_sample, *state_conv_a, *state_conv_qkv, *state_delta, *p_prompt, *p_sample;
    const float *f1_pre, *f1_post, *f1_wg, *f1_wu, *f1_wd;
    const float *mix_pre, *mix_post, *w_in, *conv_a_w, *conv_qkv_w, *a_log, *dt_bias, *dn_norm, *w_out;
    const float *f2_pre, *f2_post, *f2_wg, *f2_wu, *f2_wd;
    const float *ple_pre, *ple_post, *w_ple_gate, *w_ple_proj;
    float* out; unsigned char* ws;
};

DI unsigned pk_bf16(float lo, float hi) { f32x2 f = {lo, hi}; bf16v2 b = __builtin_convertvector(f, bf16v2); return __builtin_bit_cast(unsigned, b); }
DI float bf_lo(unsigned u) { return __uint_as_float(u << 16); }
DI float bf_hi(unsigned u) { return __uint_as_float(u & 0xffff0000u); }
DI float bf2f(bf16_t b) { return __uint_as_float(((unsigned)b) << 16); }
DI float dpp_f(float v, const int ctrl_sel) {
    const int x = __float_as_int(v);
    int r;
    if (ctrl_sel == 0) r = __builtin_amdgcn_update_dpp(x, x, 0xB1, 0xF, 0xF, true);
    else if (ctrl_sel == 1) r = __builtin_amdgcn_update_dpp(x, x, 0x4E, 0xF, 0xF, true);
    else if (ctrl_sel == 2) r = __builtin_amdgcn_update_dpp(x, x, 0x141, 0xF, 0xF, true);
    else r = __builtin_amdgcn_update_dpp(x, x, 0x140, 0xF, 0xF, true);
    return __int_as_float(r);
}
DI float wave_sum(float v) {
    v += dpp_f(v, 0); v += dpp_f(v, 1); v += dpp_f(v, 2); v += dpp_f(v, 3);
    const int x = __float_as_int(v);
    return __int_as_float(__builtin_amdgcn_readlane(x, 0)) + __int_as_float(__builtin_amdgcn_readlane(x, 16)) + __int_as_float(__builtin_amdgcn_readlane(x, 32)) + __int_as_float(__builtin_amdgcn_readlane(x, 48));
}
DI int otid() { int t = threadIdx.x; asm volatile("" : "+v"(t)); return t; }
DI float sigmoidf_(float x) { return __builtin_amdgcn_rcpf(1.0f + __expf(-x)); }
DI float siluf_(float x) { return x * sigmoidf_(x); }

namespace pg8 {
constexpr int BM = 256, BK = 64, HALF = 128, HTB = HALF * BK * 2, STAGE_BYTES = 8 * HTB, NXCD = 8, WGM = 8;
DI int lds_byte(int r, int c) { const int st = (r >> 4) * 2 + (c >> 5), rr = r & 15, cc = c & 31, ob = rr * 64 + cc * 2; return st * 1024 + (ob ^ (((ob >> 9) & 1) << 5)); }
DI void stage_rc(int b, int& R, int& C) { const int st = b / 1024, sb = b % 1024, swz = sb ^ (((sb >> 9) & 1) << 5); R = (st >> 1) * 16 + swz / 64; C = (st & 1) * 32 + (swz % 64) / 2; }
DI int perm32(int rho) { const int n = rho >> 4, i = rho & 15; return 8 * (i >> 2) + 4 * n + (i & 3); }
struct Unit { int pm, pn; };
struct Gemm { const bf16_t* A; const bf16_t* Bt; int M, N, K; };
struct StaticOrder {
    int nM, nN, nwg, G, c;
    DI void init(int M, int N, int G_, int c_) { nM = M / BM; nN = N / BM; nwg = nM * nN; G = G_; c = c_; }
    DI bool next(int i, Unit& u) const {
        const long L = (long)i * G + c; if (L >= nwg) return false;
        int wgid = (int)L; { const int q = nwg / NXCD, r = nwg % NXCD, xcd = wgid % NXCD, off = wgid / NXCD; wgid = (xcd < r ? xcd * (q + 1) : r * (q + 1) + (xcd - r) * q) + off; }
        const int nig = WGM * nN, gid = wgid / nig, fm = gid * WGM, gsz = (nM - fm) < WGM ? (nM - fm) : WGM;
        u.pm = fm + ((wgid % nig) % gsz); u.pn = (wgid % nig) / gsz; return true;
    }
};
struct EpiY {
    static constexpr bool PERM = true;
    bf16_t* C; int ldc;
    DI void operator()(const f32x4 (&acc)[2][2][4][2], const Unit& u, int wr, int wc, int fr, int fq) const {
        const int row0 = u.pm * BM + wr * 64 + fr, col0 = u.pn * BM + wc * 32 + 8 * fq;
#pragma unroll
        for (int ai = 0; ai < 2; ++ai)
#pragma unroll
            for (int m = 0; m < 4; ++m) { bf16_t* rowp = C + (size_t)(row0 + ai * HALF + m * 16) * ldc + col0;
#pragma unroll
                for (int bj = 0; bj < 2; ++bj) { const f32x4 v0 = acc[ai][bj][m][0], v1 = acc[ai][bj][m][1];
                    u32x4 w; w.x = pk_bf16(v0[0], v0[1]); w.y = pk_bf16(v0[2], v0[3]); w.z = pk_bf16(v1[0], v1[1]); w.w = pk_bf16(v1[2], v1[3]);
                    *(u32x4*)(rowp + bj * HALF) = w; } }
    }
};
struct EpiGate {
    static constexpr bool PERM = true;
    bf16_t* C; int ldc;
    DI void operator()(const f32x4 (&acc)[2][2][4][2], const Unit& u, int wr, int wc, int fr, int fq) const {
        const int row0 = u.pm * BM + wr * 64 + fr, col0 = u.pn * BM + wc * 32 + 8 * fq;
#pragma unroll
        for (int ai = 0; ai < 2; ++ai)
#pragma unroll
            for (int m = 0; m < 4; ++m) { bf16_t* rowp = C + (size_t)(row0 + ai * HALF + m * 16) * ldc + col0;
#pragma unroll
                for (int bj = 0; bj < 2; ++bj) { const f32x4 v0 = acc[ai][bj][m][0], v1 = acc[ai][bj][m][1];
                    const u32x4 pp = *(const u32x4*)(rowp + bj * HALF);
                    u32x4 w; w.x = pk_bf16(sigmoidf_(v0[0]) * bf_lo(pp.x), sigmoidf_(v0[1]) * bf_hi(pp.x)); w.y = pk_bf16(sigmoidf_(v0[2]) * bf_lo(pp.y), sigmoidf_(v0[3]) * bf_hi(pp.y));
                    w.z = pk_bf16(sigmoidf_(v1[0]) * bf_lo(pp.z), sigmoidf_(v1[1]) * bf_hi(pp.z)); w.w = pk_bf16(sigmoidf_(v1[2]) * bf_lo(pp.w), sigmoidf_(v1[3]) * bf_hi(pp.w));
                    *(u32x4*)(rowp + bj * HALF) = w; } }
    }
};
struct EpiSwiglu {
    static constexpr bool PERM = true;
    bf16_t* O;
    DI void operator()(const f32x4 (&acc)[2][2][4][2], const Unit& u, int wr, int wc, int fr, int fq) const {
        const int row0 = u.pm * BM + wr * 64 + fr, col0 = u.pn * 128 + wc * 32 + 8 * fq;
#pragma unroll
        for (int ai = 0; ai < 2; ++ai)
#pragma unroll
            for (int m = 0; m < 4; ++m) { bf16_t* rowp = O + (size_t)(row0 + ai * HALF + m * 16) * FF + col0;
                float v[8];
#pragma unroll
                for (int n = 0; n < 2; ++n) { const f32x4 g = acc[ai][0][m][n], uu = acc[ai][1][m][n];
#pragma unroll
                    for (int j = 0; j < 4; j += 2) {
                        const float e0 = 1.0f + __expf(-fmaxf(g[j], -30.f)), e1 = 1.0f + __expf(-fmaxf(g[j + 1], -30.f));
                        const float r = __builtin_amdgcn_rcpf(e0 * e1);
                        v[4 * n + j] = g[j] * uu[j] * (r * e1); v[4 * n + j + 1] = g[j + 1] * uu[j + 1] * (r * e0); } }
                u32x4 w; w.x = pk_bf16(v[0], v[1]); w.y = pk_bf16(v[2], v[3]); w.z = pk_bf16(v[4], v[5]); w.w = pk_bf16(v[6], v[7]);
                *(u32x4*)rowp = w; }
    }
};
struct EpiProj {
    static constexpr bool PERM = true;
    bf16_t* O; float* AB;
    DI void operator()(const f32x4 (&acc)[2][2][4][2], const Unit& u, int wr, int wc, int fr, int fq) const {
        const int row0 = u.pm * BM + wr * 64 + fr;
        if (u.pn < 28) {
            const int col0 = u.pn * BM + wc * 32 + 8 * fq;
#pragma unroll
            for (int ai = 0; ai < 2; ++ai)
#pragma unroll
                for (int m = 0; m < 4; ++m) { bf16_t* rowp = O + (size_t)(row0 + ai * HALF + m * 16) * NPROJ + col0;
#pragma unroll
                    for (int bj = 0; bj < 2; ++bj) { const f32x4 v0 = acc[ai][bj][m][0], v1 = acc[ai][bj][m][1];
                        u32x4 w; w.x = pk_bf16(v0[0], v0[1]); w.y = pk_bf16(v0[2], v0[3]); w.z = pk_bf16(v1[0], v1[1]); w.w = pk_bf16(v1[2], v1[3]);
                        *(u32x4*)(rowp + bj * HALF) = w; } }
        } else if (wc == 0 && fq < 2) {
#pragma unroll
            for (int ai = 0; ai < 2; ++ai)
#pragma unroll
                for (int m = 0; m < 4; ++m) { float* rowp = AB + (size_t)(row0 + ai * HALF + m * 16) * 16 + 8 * fq;
                    *(f32x4*)(rowp) = acc[ai][0][m][0]; *(f32x4*)(rowp + 4) = acc[ai][0][m][1]; }
        }
    }
};

template <class Epi>
DI void gemm_phase(LAS unsigned char* lds, const Gemm g, const StaticOrder& S, const Epi& E) {
    int tid = threadIdx.x; asm volatile("" : "+v"(tid));
    const int wid = __builtin_amdgcn_readfirstlane(tid >> 6), lane = tid & 63, wr = wid >> 2, wc = wid & 3, fr = lane & 15, fq = lane >> 4;
    const int K = g.K, nt = K / BK;
    unsigned voffA[2], voffB[2];
#pragma unroll
    for (int i = 0; i < 2; ++i) { int R, C; stage_rc(tid * 16 + i * 8192, R, C); const int Rb = Epi::PERM ? ((R & ~31) + perm32(R & 31)) : R;
        voffA[i] = (unsigned)(R * K + C) * 2u; voffB[i] = (unsigned)(Rb * K + C) * 2u; }
    const size_t kstep = (size_t)(BK * 2);
    const size_t hstep = (size_t)HALF * K * 2;
    const size_t tstep = 2 * hstep;
    const unsigned ldsw = (unsigned)wid * 1024u;
    const int aoff = lds_byte(wr * 64 + fr, fq * 8), boff = lds_byte(wc * 32 + fr, fq * 8);
#define PG8_SA(b, h) (((b) * 2 + (h)) * HTB)
#define PG8_SB(b, h) ((4 + (b) * 2 + (h)) * HTB)
#define PG8_STAGE(bufoff, gbase, voff) do { _Pragma("unroll") for (int _i = 0; _i < 2; ++_i) \
        __builtin_amdgcn_global_load_lds((const unsigned*)((const char*)(gbase) + (voff)[_i]), (LAS unsigned*)(lds + (bufoff) + ldsw + _i * 8192), 16, 0, 0); } while (0)
#define PG8_LDA(dst, b, h) do { _Pragma("unroll") for (int m = 0; m < 4; ++m) _Pragma("unroll") for (int k = 0; k < 2; ++k) dst[m][k] = *(const LAS bf16x8*)(lds + PG8_SA(b, h) + aoff + m * 2048 + k * 1024); } while (0)
#define PG8_LDB(dst, b, h) do { _Pragma("unroll") for (int n = 0; n < 2; ++n) _Pragma("unroll") for (int k = 0; k < 2; ++k) dst[n][k] = *(const LAS bf16x8*)(lds + PG8_SB(b, h) + boff + n * 2048 + k * 1024); } while (0)
#define PG8_MMA(ai, bj, At, Bt) do { __builtin_amdgcn_s_setprio(1); _Pragma("unroll") for (int m = 0; m < 4; ++m) _Pragma("unroll") for (int n = 0; n < 2; ++n) _Pragma("unroll") for (int k = 0; k < 2; ++k) \
        acc[ai][bj][m][n] = __builtin_amdgcn_mfma_f32_16x16x32_bf16(Bt[n][k], At[m][k], acc[ai][bj][m][n], 0, 0, 0); __builtin_amdgcn_s_setprio(0); } while (0)
#define PG8_WAIT_V(n) asm volatile("s_waitcnt vmcnt(" #n ")" ::: "memory")
#define PG8_WAIT_L(n) asm volatile("s_waitcnt lgkmcnt(" #n ")" ::: "memory")
#define PG8_BAR __builtin_amdgcn_s_barrier()
#define PG8_SCHED __builtin_amdgcn_sched_barrier(0)
    Unit cur, nxt; int ui = 0;
    if (!S.next(0, cur)) return;
    f32x4 acc[2][2][4][2];
#pragma unroll
    for (int a = 0; a < 2; ++a)
#pragma unroll
        for (int b = 0; b < 2; ++b)
#pragma unroll
            for (int m = 0; m < 4; ++m)
#pragma unroll
                for (int n = 0; n < 2; ++n) acc[a][b][m][n] = (f32x4){0.f, 0.f, 0.f, 0.f};
    bf16x8 At[4][2], B0[2][2], B1[2][2];
    const char* cA = (const char*)g.A + (size_t)cur.pm * tstep; const char* cB = (const char*)g.Bt + (size_t)cur.pn * tstep;
    PG8_STAGE(PG8_SB(0, 0), cB, voffB); PG8_STAGE(PG8_SA(0, 0), cA, voffA); PG8_STAGE(PG8_SB(0, 1), cB + hstep, voffB); PG8_STAGE(PG8_SA(0, 1), cA + hstep, voffA);
    if (wr == 1) PG8_BAR;
    PG8_WAIT_V(4); PG8_BAR;
    PG8_STAGE(PG8_SB(1, 0), cB + kstep, voffB); PG8_STAGE(PG8_SA(1, 0), cA + kstep, voffA); PG8_STAGE(PG8_SB(1, 1), cB + hstep + kstep, voffB);
    PG8_WAIT_V(6); PG8_BAR;
    for (;;) {
        const bool has_next = S.next(ui + 1, nxt);
        const char* nA = has_next ? (const char*)g.A + (size_t)nxt.pm * tstep : cA; const char* nB = has_next ? (const char*)g.Bt + (size_t)nxt.pn * tstep : cB;
        for (int t = 0; t < nt; t += 2) {
            const bool last = (t == nt - 2);
            const char* a1 = cA + (size_t)(t + 1) * kstep;
            const char* a2 = last ? nA : cA + (size_t)(t + 2) * kstep; const char* b2 = last ? nB : cB + (size_t)(t + 2) * kstep;
            const char* a3 = a2 + kstep; const char* b3 = b2 + kstep;
            PG8_LDB(B0, 0, 0); PG8_SCHED; PG8_LDA(At, 0, 0); PG8_STAGE(PG8_SA(1, 1), a1 + hstep, voffA);
            PG8_WAIT_L(8); PG8_BAR; PG8_WAIT_L(0); PG8_MMA(0, 0, At, B0); PG8_BAR; PG8_SCHED;
            PG8_LDB(B1, 0, 1); PG8_STAGE(PG8_SB(0, 0), b2, voffB);
            PG8_BAR; PG8_WAIT_L(0); PG8_MMA(0, 1, At, B1); PG8_BAR;
            PG8_LDA(At, 0, 1); PG8_STAGE(PG8_SA(0, 0), a2, voffA);
            PG8_BAR; PG8_WAIT_L(0); PG8_MMA(1, 0, At, B0); PG8_BAR; PG8_SCHED;
            PG8_STAGE(PG8_SB(0, 1), b2 + hstep, voffB);
            PG8_WAIT_V(6); PG8_BAR; PG8_MMA(1, 1, At, B1); PG8_BAR;
            PG8_LDB(B0, 1, 0); PG8_SCHED; PG8_LDA(At, 1, 0); PG8_STAGE(PG8_SA(0, 1), a2 + hstep, voffA);
            PG8_WAIT_L(8); PG8_BAR; PG8_WAIT_L(0); PG8_MMA(0, 0, At, B0); PG8_BAR; PG8_SCHED;
            PG8_LDB(B1, 1, 1); PG8_STAGE(PG8_SB(1, 0), b3, voffB);
            PG8_BAR; PG8_WAIT_L(0); PG8_MMA(0, 1, At, B1); PG8_BAR;
            PG8_LDA(At, 1, 1); PG8_STAGE(PG8_SA(1, 0), a3, voffA);
            PG8_BAR; PG8_WAIT_L(0); PG8_MMA(1, 0, At, B0); PG8_BAR; PG8_SCHED;
            PG8_STAGE(PG8_SB(1, 1), b3 + hstep, voffB);
            PG8_WAIT_V(6); PG8_BAR; PG8_MMA(1, 1, At, B1); PG8_BAR;
        }
        E(acc, cur, wr, wc, fr, fq);
        if (!has_next) break;
#pragma unroll
        for (int a = 0; a < 2; ++a)
#pragma unroll
            for (int b = 0; b < 2; ++b)
#pragma unroll
                for (int m = 0; m < 4; ++m)
#pragma unroll
                    for (int n = 0; n < 2; ++n) acc[a][b][m][n] = (f32x4){0.f, 0.f, 0.f, 0.f};
        cur = nxt; cA = nA; cB = nB; ++ui;
    }
    PG8_WAIT_V(0);
    if (wr == 0) PG8_BAR;
    PG8_BAR;
#undef PG8_SA
#undef PG8_SB
#undef PG8_STAGE
#undef PG8_LDA
#undef PG8_LDB
#undef PG8_MMA
#undef PG8_WAIT_V
#undef PG8_WAIT_L
#undef PG8_BAR
#undef PG8_SCHED
}
}

template <class Epi>
DI void run_gemm(LAS unsigned char* lds, const bf16_t* A, const bf16_t* Bt, int M, int N, int K, const Epi& E) {
    pg8::Gemm g{A, Bt, M, N, K}; pg8::StaticOrder S; S.init(M, N, (int)gridDim.x, (int)blockIdx.x);
    pg8::gemm_phase<Epi>(lds, g, S, E);
}

template <int MODE>
DI void small_gemm(unsigned char* lds, const bf16_t* __restrict__ A, const bf16_t* __restrict__ Bt, int K, bf16_t* Yrows) {
    const int tid = otid(), wid = tid >> 6, lane = tid & 63, fr = lane & 15, fq = lane >> 4;
    const int wm = wid >> 1, wn = wid & 1, nk = K >> 7;
    const int lr = tid >> 4, lc = tid & 15;
    constexpr int RS = 272, BUF = 64 * RS;
    for (int tile = blockIdx.x; tile < 256; tile += gridDim.x) {
        const int ms = tile >> 5, ns = tile & 31;
        const bf16_t* ap = A + (size_t)(ms * 64 + lr) * K + lc * 8;
        const bf16_t* bp = Bt + (size_t)(ns * 64 + lr) * K + lc * 8;
        const size_t r32 = (size_t)32 * K;
        u32x4 ra[4][2], rb[4][2];
#define SG_LOAD(j, t) do { if ((t) < nk) { ra[j][0] = *(const u32x4*)(ap + (t) * 128); ra[j][1] = *(const u32x4*)(ap + r32 + (t) * 128); rb[j][0] = *(const u32x4*)(bp + (t) * 128); rb[j][1] = *(const u32x4*)(bp + r32 + (t) * 128); } } while (0)
#define SG_WRITE(j, t) do { if ((t) < nk) { unsigned char* d = lds + ((t) & 1) * (2 * BUF) + lr * RS + lc * 16; \
        *(u32x4*)d = ra[j][0]; *(u32x4*)(d + 32 * RS) = ra[j][1]; *(u32x4*)(d + BUF) = rb[j][0]; *(u32x4*)(d + BUF + 32 * RS) = rb[j][1]; } } while (0)
#define SG_COMPUTE(t) do { const unsigned char* bA = lds + ((t) & 1) * (2 * BUF) + (16 * wm + fr) * RS + fq * 16; const unsigned char* bB = lds + ((t) & 1) * (2 * BUF) + BUF + (32 * wn + fr) * RS + fq * 16; \
        _Pragma("unroll") for (int kk = 0; kk < 4; ++kk) { const bf16x8 fa = *(const bf16x8*)(bA + kk * 64), f0 = *(const bf16x8*)(bB + kk * 64), f1 = *(const bf16x8*)(bB + 16 * RS + kk * 64); \
            acc0 = __builtin_amdgcn_mfma_f32_16x16x32_bf16(f0, fa, acc0, 0, 0, 0); acc1 = __builtin_amdgcn_mfma_f32_16x16x32_bf16(f1, fa, acc1, 0, 0, 0); } } while (0)
#define SG_STEP(j, t) do { if ((t) < nk) { __syncthreads(); SG_COMPUTE(t); SG_WRITE(((j) + 1) & 3, (t) + 1); SG_LOAD(j, (t) + 4); } } while (0)
        f32x4 acc0 = {0.f, 0.f, 0.f, 0.f}, acc1 = {0.f, 0.f, 0.f, 0.f};
        SG_LOAD(0, 0); SG_LOAD(1, 1); SG_LOAD(2, 2); SG_LOAD(3, 3);
        SG_WRITE(0, 0);
        for (int t = 0; t < nk; t += 4) { SG_STEP(0, t); SG_STEP(1, t + 1); SG_STEP(2, t + 2); SG_STEP(3, t + 3); }
#undef SG_LOAD
#undef SG_WRITE
#undef SG_COMPUTE
#undef SG_STEP
        bf16_t* yp = Yrows + (size_t)(ms * 64 + 16 * wm + fr) * DM + ns * 64 + 32 * wn + 4 * fq;
        if (MODE == 1) {
            const u32x2 p0 = *(const u32x2*)yp, p1 = *(const u32x2*)(yp + 16);
            acc0[0] = sigmoidf_(acc0[0]) * bf_lo(p0.x); acc0[1] = sigmoidf_(acc0[1]) * bf_hi(p0.x); acc0[2] = sigmoidf_(acc0[2]) * bf_lo(p0.y); acc0[3] = sigmoidf_(acc0[3]) * bf_hi(p0.y);
            acc1[0] = sigmoidf_(acc1[0]) * bf_lo(p1.x); acc1[1] = sigmoidf_(acc1[1]) * bf_hi(p1.x); acc1[2] = sigmoidf_(acc1[2]) * bf_lo(p1.y); acc1[3] = sigmoidf_(acc1[3]) * bf_hi(p1.y);
        }
        u32x2 w0, w1; w0.x = pk_bf16(acc0[0], acc0[1]); w0.y = pk_bf16(acc0[2], acc0[3]); w1.x = pk_bf16(acc1[0], acc1[1]); w1.y = pk_bf16(acc1[2], acc1[3]);
        *(u32x2*)yp = w0; *(u32x2*)(yp + 16) = w1;
        __syncthreads();
    }
}

DI int rowmap(int n, int mode) { return mode == 0 ? n : ((n >> 7) * 256 + (mode == 2 ? 128 : 0) + (n & 127)); }
struct ConvTile { const float* src; bf16_t* dst; const float* gain; int K, N, mode, k0, n0; bool valid; };
DI ConvTile conv_decode(const Params& p, int g) {
    ConvTile c; c.valid = false; c.src = nullptr; c.dst = nullptr; c.gain = nullptr; c.K = 0; c.N = 0; c.mode = 0; c.k0 = 0; c.n0 = 0;
    int base = 0;
#define CJOB(S, D, G, KK, NN, MM) { const int nTn = ((NN) + 255) >> 8, nt = ((KK) >> 6) * nTn; if (g >= base && g < base + nt) { const int t = g - base, tk = t / nTn; \
        c.src = (S); c.dst = (bf16_t*)(p.ws + (D)); c.gain = (G); c.K = (KK); c.N = (NN); c.mode = (MM); c.k0 = tk * 64; c.n0 = (t - tk * nTn) * 256; c.valid = true; } base += nt; }
    CJOB(p.f1_wg, OFF_WGU1, p.f1_pre, 2048, 5632, 1)
    CJOB(p.f1_wu, OFF_WGU1, p.f1_pre, 2048, 5632, 2)
    CJOB(p.w_in, OFF_WIN, p.mix_pre, 2048, NINR, 0)
    CJOB(p.f1_wd, OFF_WD1, nullptr, 5632, 2048, 0)
    CJOB(p.w_out, OFF_WOUT, nullptr, 2048, 2048, 0)
    CJOB(p.w_ple_gate, OFF_WPG, p.ple_pre, 2048, 2048, 0)
    CJOB(p.w_ple_proj, OFF_WPP, nullptr, 256, 2048, 0)
    CJOB(p.f2_wg, OFF_WGU2, p.f2_pre, 2048, 5632, 1)
    CJOB(p.f2_wu, OFF_WGU2, p.f2_pre, 2048, 5632, 2)
    CJOB(p.f2_wd, OFF_WD2, nullptr, 5632, 2048, 0)
#undef CJOB
    return c;
}
constexpr int CT_P0 = 2 * 704 + 928, CT_WD1 = CT_P0 + 704, CT_MISC = CT_WD1 + 256 + 256 + 32, CONV_TILES = CT_MISC + 3 * 704;
DI void conv_load(const ConvTile& c, int tid, f32x4 (&r)[8]) {
    const int n4 = (tid & 63) * 4, kr = (tid >> 6) * 2;
#pragma unroll
    for (int ps = 0; ps < 4; ++ps) {
        const int kk = ps * 16 + kr;
        f32x4 a = {0.f, 0.f, 0.f, 0.f}, b = {0.f, 0.f, 0.f, 0.f};
        if (c.valid && c.n0 + n4 < c.N) { a = __builtin_nontemporal_load((const f32x4*)(c.src + (size_t)(c.k0 + kk) * c.N + c.n0 + n4)); b = __builtin_nontemporal_load((const f32x4*)(c.src + (size_t)(c.k0 + kk + 1) * c.N + c.n0 + n4)); }
        r[2 * ps] = a; r[2 * ps + 1] = b;
    }
}
DI void conv_store(const ConvTile& c, int tid, const f32x4 (&r)[8], unsigned* lds) {
    const int n4 = (tid & 63) * 4, kr = (tid >> 6) * 2;
#pragma unroll
    for (int ps = 0; ps < 4; ++ps) {
        const int kk = ps * 16 + kr;
        f32x4 a = r[2 * ps], b = r[2 * ps + 1];
        if (c.gain) { const float g0 = c.gain[c.k0 + kk], g1 = c.gain[c.k0 + kk + 1]; a *= g0; b *= g1; }
#pragma unroll
        for (int i = 0; i < 4; ++i) lds[(n4 + i) * 33 + (kk >> 1)] = pk_bf16(a[i], b[i]);
    }
    __syncthreads();
#pragma unroll
    for (int q2 = 0; q2 < 4; ++q2) {
        const int q = tid + q2 * 512, n = q >> 3, kc = q & 7;
        u32x4 w; w.x = lds[n * 33 + kc * 4 + 0]; w.y = lds[n * 33 + kc * 4 + 1]; w.z = lds[n * 33 + kc * 4 + 2]; w.w = lds[n * 33 + kc * 4 + 3];
        const int nn = c.n0 + n;
        if (c.mode == 0 || nn < c.N) *(u32x4*)(c.dst + (size_t)rowmap(nn, c.mode) * c.K + c.k0 + kc * 8) = w;
    }
    __syncthreads();
}
DI void conv_phase(const Params& p, unsigned* lds, int t_begin, int t_end, int rank, int nranks) {
    const int tid = otid(), G = nranks;
    int g = t_begin + rank;
    if (g >= t_end) return;
    ConvTile c0 = conv_decode(p, g), c1;
    f32x4 r0[8], r1[8];
    conv_load(c0, tid, r0);
    for (;;) {
        c1 = conv_decode(p, g + G); if (g + G >= t_end) c1.valid = false;
        conv_load(c1, tid, r1);
        conv_store(c0, tid, r0, lds);
        if (!c1.valid) break;
        c0 = conv_decode(p, g + 2 * G); if (g + 2 * G >= t_end) c0.valid = false;
        conv_load(c0, tid, r0);
        conv_store(c1, tid, r1, lds);
        if (!c0.valid) break;
        g += 2 * G;
    }
}

DI void tail_conv(const Params& p, unsigned* lds, int nwg, int t_begin, int t_end) {
    const int G = gridDim.x, rounds = (nwg + G - 1) / G; int idle0 = nwg - (rounds - 1) * G; if (idle0 >= G) idle0 = 0;
    if ((int)blockIdx.x >= idle0) conv_phase(p, lds, t_begin, t_end, (int)blockIdx.x - idle0, G - idle0);
}

DI void row_phase(const Params& p, int which, bool dummy = false) {
    const int tid = otid(), lane = tid & 63, gw = blockIdx.x * 8 + (tid >> 6), nw = gridDim.x * 8;
    const bf16_t* Y = (const bf16_t*)(p.ws + OFF_Y); const bf16_t* H = (const bf16_t*)(p.ws + OFF_H); const float* RINV = (const float*)(p.ws + OFF_RINV);
    bf16_t* Hd = (bf16_t*)(p.ws + (dummy ? OFF_YC : OFF_H)); float* RINVd = (float*)(p.ws + (dummy ? OFF_AB : OFF_RINV));
    const float* gpost = which == 1 ? p.f1_post : which == 2 ? p.mix_post : which == 3 ? p.f2_post : p.ple_post;
    const float scale = (which == 1 || which == 3) ? 0.5f : 1.0f;
    for (int row = gw; row < MT; row += nw) {
        f32x4 x[8];
        if (which <= 1) {
            const float* xs = row < MP ? p.x_prompt + (size_t)row * DM : p.x_sample + (size_t)(row - MP) * DM;
#pragma unroll
            for (int it = 0; it < 8; ++it) x[it] = *(const f32x4*)(xs + (it * 64 + lane) * 4);
        } else {
            const float ri = RINV[row];
#pragma unroll
            for (int it = 0; it < 8; ++it) { const u32x2 hh = *(const u32x2*)(H + (size_t)row * DM + (it * 64 + lane) * 4);
                x[it] = (f32x4){bf_lo(hh.x) * ri, bf_hi(hh.x) * ri, bf_lo(hh.y) * ri, bf_hi(hh.y) * ri}; }
        }
        if (which > 0) {
            f32x4 y[8]; float ss = 0.f;
#pragma unroll
            for (int it = 0; it < 8; ++it) { const u32x2 yy = __builtin_nontemporal_load((const u32x2*)(Y + (size_t)row * DM + (it * 64 + lane) * 4));
                y[it] = (f32x4){bf_lo(yy.x), bf_hi(yy.x), bf_lo(yy.y), bf_hi(yy.y)}; ss += y[it][0] * y[it][0] + y[it][1] * y[it][1] + y[it][2] * y[it][2] + y[it][3] * y[it][3]; }
            ss = wave_sum(ss);
            const float r = rsqrtf(ss * (1.0f / DM) + EPS) * scale;
#pragma unroll
            for (int it = 0; it < 8; ++it) { const f32x4 gp = *(const f32x4*)(gpost + (it * 64 + lane) * 4);
#pragma unroll
                for (int j = 0; j < 4; ++j) x[it][j] += y[it][j] * r * gp[j]; }
        }
        if (which == 4) {
#pragma unroll
            for (int it = 0; it < 8; ++it) __builtin_nontemporal_store(x[it], (f32x4*)(p.out + (size_t)row * DM + (it * 64 + lane) * 4));
        } else {
            float ss = 0.f;
#pragma unroll
            for (int it = 0; it < 8; ++it) ss += x[it][0] * x[it][0] + x[it][1] * x[it][1] + x[it][2] * x[it][2] + x[it][3] * x[it][3];
            ss = wave_sum(ss);
            const float ms = ss * (1.0f / DM) + EPS, r = rsqrtf(ms);
            if (lane == 0) RINVd[row] = ms * r;
#pragma unroll
            for (int it = 0; it < 8; ++it) { u32x2 w; w.x = pk_bf16(x[it][0] * r, x[it][1] * r); w.y = pk_bf16(x[it][2] * r, x[it][3] * r);
                *(u32x2*)(Hd + (size_t)row * DM + (it * 64 + lane) * 4) = w; }
        }
    }
}

DI void mixer_a_phase(const Params& p) {
    const bf16_t* PJ = (const bf16_t*)(p.ws + OFF_BIG); bf16_t* YC = (bf16_t*)(p.ws + OFF_YC);
    const int gt = ((int)blockIdx.x - 32) * 512 + otid(), nthr = ((int)gridDim.x - 32) * 512;
    for (int it = gt; it < MT * 128; it += nthr) {
        const int row = it >> 7, c = (it & 127) * 8;
        int tt, T, s = 0, b = 0;
        if (row < MP) { tt = row & 2047; T = 2048; b = row >> 11; } else { s = (row - MP) >> 2; tt = (row - MP) & 3; T = 4; }
        float u[3][8];
#pragma unroll
        for (int j = 0; j < 3; ++j) {
            const int tp = tt - 2 + j;
            if (tp >= 0) {
                const bf16_t* rp = PJ + (size_t)(row - 2 + j) * NPROJ;
                const u32x4 a = *(const u32x4*)(rp + 1024 + c), h = *(const u32x4*)(rp + 2048 + c);
#pragma unroll
                for (int e = 0; e < 4; ++e) { u[j][2 * e] = bf_lo(a[e]) * bf_lo(h[e]); u[j][2 * e + 1] = bf_hi(a[e]) * bf_hi(h[e]); }
            } else if (row >= MP) {
                const float* sp = p.state_conv_a + ((size_t)s * 2 + (2 + tp)) * 1024 + c;
                const f32x4 a = *(const f32x4*)sp, bq = *(const f32x4*)(sp + 4);
#pragma unroll
                for (int e = 0; e < 4; ++e) { u[j][e] = a[e]; u[j][4 + e] = bq[e]; }
            } else {
#pragma unroll
                for (int e = 0; e < 8; ++e) u[j][e] = 0.f;
            }
        }
        const u32x4 gb = *(const u32x4*)(PJ + (size_t)row * NPROJ + c);
        float y[8];
#pragma unroll
        for (int e = 0; e < 8; ++e) {
            const float w0 = p.conv_a_w[c + e], w1 = p.conv_a_w[1024 + c + e], w2 = p.conv_a_w[2048 + c + e];
            const float g = (e & 1) ? bf_hi(gb[e >> 1]) : bf_lo(gb[e >> 1]);
            y[e] = g * (w0 * u[0][e] + w1 * u[1][e] + w2 * u[2][e]);
        }
        u32x4 w; w.x = pk_bf16(y[0], y[1]); w.y = pk_bf16(y[2], y[3]); w.z = pk_bf16(y[4], y[5]); w.w = pk_bf16(y[6], y[7]);
        *(u32x4*)(YC + (size_t)row * DM + c) = w;
        if (tt >= T - 2) {
            float* op = (row < MP) ? p.out + O_CA_P + ((size_t)b * 2 + (tt - (T - 2))) * 1024 + c : p.out + O_CA_S + ((size_t)s * 2 + (tt - 2)) * 1024 + c;
            *(f32x4*)op = (f32x4){u[2][0], u[2][1], u[2][2], u[2][3]}; *(f32x4*)(op + 4) = (f32x4){u[2][4], u[2][5], u[2][6], u[2][7]};
        }
    }
    for (int it = gt; it < (4 + 128) * 3 * 384; it += nthr) {
        const int c = (it % 384) * 8, rj = it / 384, seq = rj / 3, j = rj % 3;
        const int row = seq < 4 ? seq * 2048 + 2045 + j : MP + (seq - 4) * 4 + 1 + j;
        float* op = seq < 4 ? p.out + O_CQ_P + ((size_t)seq * 3 + j) * 3072 + c : p.out + O_CQ_S + ((size_t)(seq - 4) * 3 + j) * 3072 + c;
        const u32x4 a = *(const u32x4*)(PJ + (size_t)row * NPROJ + 3072 + c);
        *(f32x4*)op = (f32x4){bf_lo(a[0]), bf_hi(a[0]), bf_lo(a[1]), bf_hi(a[1])}; *(f32x4*)(op + 4) = (f32x4){bf_lo(a[2]), bf_hi(a[2]), bf_lo(a[3]), bf_hi(a[3])};
    }
}

DI float softplusf_(float x) { return x > 20.f ? x : log1pf(__expf(x)); }

constexpr int PL_QS = 0, PL_KS = 17408, PL_KT = 34816, PL_VT = 53248, PL_AS = 71680, PL_TF = 88064, PL_TC = 97280, PL_XT = 99840, PL_T1 = 102400, PL_T2 = 111616, PL_SM = 120832;
DI bf16_t f2bf(float x) { return (bf16_t)(pk_bf16(x, 0.f) & 0xffffu); }
DI void prep_phase(const Params& p, unsigned char* lds) {
    int tid = threadIdx.x; asm volatile("" : "+v"(tid));
    const int wid = tid >> 6, lane = tid & 63, fr = lane & 15, fq = lane >> 4;
    bf16_t* qs = (bf16_t*)(lds + PL_QS); bf16_t* ks = (bf16_t*)(lds + PL_KS); bf16_t* kT = (bf16_t*)(lds + PL_KT); bf16_t* vT = (bf16_t*)(lds + PL_VT);
    float* As = (float*)(lds + PL_AS); bf16_t* TF = (bf16_t*)(lds + PL_TF); bf16_t* TC = (bf16_t*)(lds + PL_TC); bf16_t* XT = (bf16_t*)(lds + PL_XT);
    bf16_t* T1 = (bf16_t*)(lds + PL_T1); bf16_t* T2 = (bf16_t*)(lds + PL_T2); float* sm = (float*)(lds + PL_SM);
    const bf16_t* PJ = (const bf16_t*)(p.ws + OFF_BIG); const float* AB = (const float*)(p.ws + OFF_AB);
    for (int item0 = blockIdx.x; item0 < 1024 * (PROBE_DUP == 6 ? 2 : 1); item0 += gridDim.x) {
        const int item = item0 & 1023, bh = item >> 5, n = item & 31, b = bh >> 3, h = bh & 7, t0 = n * 64;
        unsigned char* DI_ = p.ws + OFF_Y + (size_t)item * DITEM;
        {
            const int tl0 = wid * 8, cb = h * 128 + 2 * lane;
            float wq[4][2], wk[4][2], wv[4][2];
#pragma unroll
            for (int j = 0; j < 4; ++j) { const f32x2 a = *(const f32x2*)(p.conv_qkv_w + j * 3072 + cb), bq = *(const f32x2*)(p.conv_qkv_w + j * 3072 + 1024 + cb), c = *(const f32x2*)(p.conv_qkv_w + j * 3072 + 2048 + cb);
                wq[j][0] = a.x; wq[j][1] = a.y; wk[j][0] = bq.x; wk[j][1] = bq.y; wv[j][0] = c.x; wv[j][1] = c.y; }
            const float Aexp = __expf(p.a_log[h]), dtb = p.dt_bias[h];
            unsigned xr[11][3];
#pragma unroll
            for (int i = 0; i < 11; ++i) {
                const int tt = t0 + tl0 - 3 + i; const int ttc = tt < 0 ? 0 : tt; const unsigned msk = tt < 0 ? 0u : 0xffffffffu;
                const bf16_t* rp = PJ + (size_t)(b * 2048 + ttc) * NPROJ + 3072 + cb;
                xr[i][0] = *(const unsigned*)rp & msk; xr[i][1] = *(const unsigned*)(rp + 1024) & msk; xr[i][2] = *(const unsigned*)(rp + 2048) & msk;
            }
            if (lane < 8) {
                const size_t row = (size_t)b * 2048 + t0 + tl0 + lane;
                const float a = AB[row * 16 + h], bb = AB[row * 16 + 8 + h];
                sm[tl0 + lane] = -Aexp * softplusf_(a + dtb); sm[64 + tl0 + lane] = sigmoidf_(bb);
            }
#pragma unroll
            for (int i = 0; i < 8; ++i) {
                float q0 = 0.f, q1 = 0.f, k0 = 0.f, k1 = 0.f, v0 = 0.f, v1 = 0.f;
#pragma unroll
                for (int j = 0; j < 4; ++j) {
                    q0 += wq[j][0] * bf_lo(xr[i + j][0]); q1 += wq[j][1] * bf_hi(xr[i + j][0]);
                    k0 += wk[j][0] * bf_lo(xr[i + j][1]); k1 += wk[j][1] * bf_hi(xr[i + j][1]);
                    v0 += wv[j][0] * bf_lo(xr[i + j][2]); v1 += wv[j][1] * bf_hi(xr[i + j][2]);
                }
                q0 = siluf_(q0); q1 = siluf_(q1); k0 = siluf_(k0); k1 = siluf_(k1); v0 = siluf_(v0); v1 = siluf_(v1);
                const float sq = wave_sum(q0 * q0 + q1 * q1), sk = wave_sum(k0 * k0 + k1 * k1);
                const float rq = rsqrtf(sq + EPS) * 0.08838834764831845f, rk = rsqrtf(sk + EPS);
                const int tl = tl0 + i;
                const unsigned kk = pk_bf16(k0 * rk, k1 * rk), vv = pk_bf16(v0, v1);
                *(unsigned*)(qs + tl * 136 + 2 * lane) = pk_bf16(q0 * rq, q1 * rq);
                *(unsigned*)(ks + tl * 136 + 2 * lane) = kk;
                kT[(2 * lane) * 72 + tl] = (bf16_t)(kk & 0xffffu); kT[(2 * lane + 1) * 72 + tl] = (bf16_t)(kk >> 16);
                vT[(2 * lane) * 72 + tl] = (bf16_t)(vv & 0xffffu); vT[(2 * lane + 1) * 72 + tl] = (bf16_t)(vv >> 16);
            }
        }
        __syncthreads();
        if (tid < 64) {
            float acc = 0.f, mine = 0.f;
            for (int j = 0; j < 64; ++j) { acc += sm[j]; if (j == tid) mine = acc; }
            sm[128 + tid] = mine; sm[192 + tid] = sm[64 + tid] * __expf(mine); sm[256 + tid] = __expf(mine); sm[320 + tid] = __expf(acc - mine);
            if (tid == 63) ((float*)(p.ws + OFF_GAM))[item] = __expf(acc);
        }
        __syncthreads();
        {
            const int ib = wid >> 1;
            bf16_t* QKM = (bf16_t*)(DI_ + D_QKM);
#pragma unroll
            for (int jj2 = 0; jj2 < 2; ++jj2) {
                const int jb = 2 * (wid & 1) + jj2;
                if (jb <= ib) {
                    f32x4 aK = {0.f, 0.f, 0.f, 0.f}, aQ = {0.f, 0.f, 0.f, 0.f};
#pragma unroll
                    for (int kk = 0; kk < 4; ++kk) {
                        const bf16x8 fa_k = *(const bf16x8*)(ks + (ib * 16 + fr) * 136 + kk * 32 + fq * 8);
                        const bf16x8 fa_q = *(const bf16x8*)(qs + (ib * 16 + fr) * 136 + kk * 32 + fq * 8);
                        const bf16x8 fb = *(const bf16x8*)(ks + (jb * 16 + fr) * 136 + kk * 32 + fq * 8);
                        aK = __builtin_amdgcn_mfma_f32_16x16x32_bf16(fa_k, fb, aK, 0, 0, 0);
                        aQ = __builtin_amdgcn_mfma_f32_16x16x32_bf16(fa_q, fb, aQ, 0, 0, 0);
                    }
#pragma unroll
                    for (int jj = 0; jj < 4; ++jj) {
                        const int i = ib * 16 + fq * 4 + jj, j = jb * 16 + fr;
                        const float dec = (i >= j) ? __expf(sm[128 + i] - sm[128 + j]) : 0.f;
                        As[i * 64 + j] = (i > j) ? sm[64 + i] * aK[jj] * dec : 0.f;
                        QKM[i * 64 + j] = f2bf(aQ[jj] * dec);
                    }
                } else {
#pragma unroll
                    for (int jj = 0; jj < 4; ++jj) QKM[(ib * 16 + fq * 4 + jj) * 64 + jb * 16 + fr] = 0;
                }
            }
            {
                const int i = tid >> 3, d0 = (tid & 7) * 16; const float e = sm[256 + i];
                bf16_t* QG = (bf16_t*)(DI_ + D_QG);
#pragma unroll
                for (int hhalf = 0; hhalf < 2; ++hhalf) {
                    const u32x4 v = *(const u32x4*)(qs + i * 136 + d0 + 8 * hhalf);
                    u32x4 w; w.x = pk_bf16(bf_lo(v.x) * e, bf_hi(v.x) * e); w.y = pk_bf16(bf_lo(v.y) * e, bf_hi(v.y) * e); w.z = pk_bf16(bf_lo(v.z) * e, bf_hi(v.z) * e); w.w = pk_bf16(bf_lo(v.w) * e, bf_hi(v.w) * e);
                    *(u32x4*)(QG + i * 128 + d0 + 8 * hhalf) = w;
                }
            }
            {
                const int d = tid >> 2, j0 = (tid & 3) * 16;
                bf16_t* KDT = (bf16_t*)(DI_ + D_KDT);
#pragma unroll
                for (int hhalf = 0; hhalf < 2; ++hhalf) {
                    const int jj0 = j0 + 8 * hhalf;
                    const u32x4 v = *(const u32x4*)(kT + d * 72 + jj0);
                    const f32x4 e0 = *(const f32x4*)(sm + 320 + jj0), e1 = *(const f32x4*)(sm + 320 + jj0 + 4);
                    u32x4 w; w.x = pk_bf16(bf_lo(v.x) * e0[0], bf_hi(v.x) * e0[1]); w.y = pk_bf16(bf_lo(v.y) * e0[2], bf_hi(v.y) * e0[3]); w.z = pk_bf16(bf_lo(v.z) * e1[0], bf_hi(v.z) * e1[1]); w.w = pk_bf16(bf_lo(v.w) * e1[2], bf_hi(v.w) * e1[3]);
                    *(u32x4*)(KDT + d * 64 + jj0) = w;
                }
            }
        }
        __syncthreads();
        if (wid == 0) {
            const int c = lane & 31, hb = lane >> 5;
            const float* Ab = As + (32 * hb) * 64 + 32 * hb;
            float t[32];
#pragma unroll
            for (int i = 0; i < 32; ++i) t[i] = 0.f;
#pragma unroll
            for (int il = 0; il < 32; ++il) {
                float a = (il == c) ? 1.f : 0.f;
#pragma unroll
                for (int j4 = 0; j4 < (il + 3) / 4; ++j4) {
                    const f32x4 av = *(const f32x4*)(Ab + il * 64 + j4 * 4);
#pragma unroll
                    for (int e = 0; e < 4; ++e) if (4 * j4 + e < il) a = __builtin_fmaf(-av[e], t[4 * j4 + e], a);
                }
                asm volatile("" : "+v"(a) :: "memory");
                t[il] = a;
            }
#pragma unroll
            for (int il = 0; il < 32; ++il) { TF[(32 * hb + il) * 72 + 32 * hb + c] = f2bf(t[il]); if (hb == 0) TF[il * 72 + 32 + c] = 0; }
            if (hb == 0) {
#pragma unroll
                for (int i8 = 0; i8 < 4; ++i8) { u32x4 w; w.x = pk_bf16(t[8 * i8], t[8 * i8 + 1]); w.y = pk_bf16(t[8 * i8 + 2], t[8 * i8 + 3]); w.z = pk_bf16(t[8 * i8 + 4], t[8 * i8 + 5]); w.w = pk_bf16(t[8 * i8 + 6], t[8 * i8 + 7]);
                    *(u32x4*)(TC + c * 40 + 8 * i8) = w; }
            }
        }
        __syncthreads();
        if (wid < 4) {
            const int tr = wid >> 1, tc = wid & 1;
            const float* ap = As + (32 + 16 * tr + fr) * 64 + fq * 8;
            const f32x4 a0 = *(const f32x4*)ap, a1 = *(const f32x4*)(ap + 4);
            u32x4 pa; pa.x = pk_bf16(a0[0], a0[1]); pa.y = pk_bf16(a0[2], a0[3]); pa.z = pk_bf16(a1[0], a1[1]); pa.w = pk_bf16(a1[2], a1[3]);
            const bf16x8 fb = *(const bf16x8*)(TC + (16 * tc + fr) * 40 + fq * 8);
            f32x4 x = {0.f, 0.f, 0.f, 0.f};
            x = __builtin_amdgcn_mfma_f32_16x16x32_bf16(__builtin_bit_cast(bf16x8, pa), fb, x, 0, 0, 0);
            u32x2 w; w.x = pk_bf16(x[0], x[1]); w.y = pk_bf16(x[2], x[3]);
            *(u32x2*)(XT + (16 * tc + fr) * 40 + 16 * tr + fq * 4) = w;
        }
        __syncthreads();
        if (wid < 4) {
            const int tr = wid >> 1, tc = wid & 1;
            const bf16x8 fa = *(const bf16x8*)(TF + (32 + 16 * tr + fr) * 72 + 32 + fq * 8);
            const bf16x8 fb = *(const bf16x8*)(XT + (16 * tc + fr) * 40 + fq * 8);
            f32x4 x = {0.f, 0.f, 0.f, 0.f};
            x = __builtin_amdgcn_mfma_f32_16x16x32_bf16(fa, fb, x, 0, 0, 0);
#pragma unroll
            for (int jj = 0; jj < 4; ++jj) TF[(32 + 16 * tr + fq * 4 + jj) * 72 + 16 * tc + fr] = f2bf(-x[jj]);
        }
        __syncthreads();
        {
            const int i = tid >> 3, j0 = (tid & 7) * 8;
            const u32x4 v = *(const u32x4*)(TF + i * 72 + j0);
            const f32x4 s0 = *(const f32x4*)(sm + 192 + j0), s1 = *(const f32x4*)(sm + 192 + j0 + 4), b0 = *(const f32x4*)(sm + 64 + j0), b1 = *(const f32x4*)(sm + 64 + j0 + 4);
            const float tv[8] = {bf_lo(v.x), bf_hi(v.x), bf_lo(v.y), bf_hi(v.y), bf_lo(v.z), bf_hi(v.z), bf_lo(v.w), bf_hi(v.w)};
            u32x4 w1, w2;
            w1.x = pk_bf16(tv[0] * s0[0], tv[1] * s0[1]); w1.y = pk_bf16(tv[2] * s0[2], tv[3] * s0[3]); w1.z = pk_bf16(tv[4] * s1[0], tv[5] * s1[1]); w1.w = pk_bf16(tv[6] * s1[2], tv[7] * s1[3]);
            w2.x = pk_bf16(tv[0] * b0[0], tv[1] * b0[1]); w2.y = pk_bf16(tv[2] * b0[2], tv[3] * b0[3]); w2.z = pk_bf16(tv[4] * b1[0], tv[5] * b1[1]); w2.w = pk_bf16(tv[6] * b1[2], tv[7] * b1[3]);
            *(u32x4*)(T1 + i * 72 + j0) = w1; *(u32x4*)(T2 + i * 72 + j0) = w2;
        }
        __syncthreads();
        {
            bf16_t* W = (bf16_t*)(DI_ + D_W); bf16_t* UT = (bf16_t*)(DI_ + D_UT);
            bf16x8 fk[2], fv[2];
#pragma unroll
            for (int kk = 0; kk < 2; ++kk) { fk[kk] = *(const bf16x8*)(kT + (16 * wid + fr) * 72 + kk * 32 + fq * 8); fv[kk] = *(const bf16x8*)(vT + (16 * wid + fr) * 72 + kk * 32 + fq * 8); }
#pragma unroll
            for (int it = 0; it < 4; ++it) {
                f32x4 aw = {0.f, 0.f, 0.f, 0.f}, au = {0.f, 0.f, 0.f, 0.f};
#pragma unroll
                for (int kk = 0; kk < 2; ++kk) {
                    const bf16x8 f1 = *(const bf16x8*)(T1 + (16 * it + fr) * 72 + kk * 32 + fq * 8);
                    const bf16x8 f2 = *(const bf16x8*)(T2 + (16 * it + fr) * 72 + kk * 32 + fq * 8);
                    aw = __builtin_amdgcn_mfma_f32_16x16x32_bf16(fk[kk], f1, aw, 0, 0, 0);
                    au = __builtin_amdgcn_mfma_f32_16x16x32_bf16(f2, fv[kk], au, 0, 0, 0);
                }
                u32x2 ww; ww.x = pk_bf16(aw[0], aw[1]); ww.y = pk_bf16(aw[2], aw[3]);
                *(u32x2*)(W + (16 * it + fr) * 128 + 16 * wid + 4 * fq) = ww;
                u32x2 wu; wu.x = pk_bf16(au[0], au[1]); wu.y = pk_bf16(au[2], au[3]);
                *(u32x2*)(UT + (16 * wid + fr) * 64 + 16 * it + 4 * fq) = wu;
            }
        }
        __syncthreads();
    }
}

constexpr int SC_W = 0, SC_QG = 16896, SC_KDT = 33792, SC_QKM = 51200, SC_UT = 59904, SC_BUF = 77312;
DI void scan_fetch(const unsigned char* src, int t, u32x4 (&r)[9]) {
#pragma unroll
    for (int i = 0; i < 9; ++i) r[i] = __builtin_nontemporal_load((const u32x4*)(src + (size_t)(t + i * 512) * 16));
}
DI void scan_put(unsigned char* buf, int t, const u32x4 (&r)[9]) {
#pragma unroll
    for (int i = 0; i < 9; ++i) {
        const int q = t + i * 512;
        int off;
        if (i < 2) { off = SC_W + (q >> 4) * 264 + (q & 15) * 16; }
        else if (i < 4) { const int qq = q - 1024; off = SC_QG + (qq >> 4) * 264 + (qq & 15) * 16; }
        else if (i < 6) { const int qq = q - 2048; off = SC_KDT + (qq >> 3) * 136 + (qq & 7) * 16; }
        else if (i < 7) { const int qq = q - 3072; off = SC_QKM + (qq >> 3) * 136 + (qq & 7) * 16; }
        else { const int qq = q - 3584; off = SC_UT + (qq >> 3) * 136 + (qq & 7) * 16; }
        *(u32x2*)(buf + off) = (u32x2){r[i].x, r[i].y}; *(u32x2*)(buf + off + 8) = (u32x2){r[i].z, r[i].w};
    }
}
DI bf16x8 lda8(const unsigned char* base, int row, int col, int stride) {
    const s16x4 lo = *(const s16x4*)(base + row * stride + col * 2), hi = *(const s16x4*)(base + row * stride + col * 2 + 16);
    return __builtin_shufflevector(lo, hi, 0, 1, 2, 3, 4, 5, 6, 7);
}
DI bf16x8 pack8(const f32x16& x, int s) {
    u32x4 pk; pk.x = pk_bf16(x[8 * s], x[8 * s + 1]); pk.y = pk_bf16(x[8 * s + 2], x[8 * s + 3]); pk.z = pk_bf16(x[8 * s + 4], x[8 * s + 5]); pk.w = pk_bf16(x[8 * s + 6], x[8 * s + 7]);
    return __builtin_bit_cast(bf16x8, pk);
}
#define MFMA32(a, b, c) __builtin_amdgcn_mfma_f32_32x32x16_bf16((a), (b), (c), 0, 0, 0)
DI void scan_phase(const Params& p, unsigned char* lds) {
    int tid = threadIdx.x; asm volatile("" : "+v"(tid));
    const int wid = tid >> 6, lane = tid & 63, r = lane & 31, hh = lane >> 5;
    const int bh = blockIdx.x, b = bh >> 3, h = bh & 7, c0 = (wid & 3) * 32;
    const unsigned char* items = p.ws + OFF_Y + (size_t)bh * 32 * DITEM;
    const float* GAM = (const float*)(p.ws + OFF_GAM) + bh * 32;
    float* ORAW = (float*)(p.ws + OFF_ORAW);
    f32x16 Sacc[4];
#pragma unroll
    for (int d = 0; d < 4; ++d)
#pragma unroll
        for (int i = 0; i < 16; ++i) Sacc[d][i] = 0.f;
    u32x4 ra[9];
    scan_fetch(items, tid, ra); scan_put(lds, tid, ra); scan_fetch(items + DITEM, tid, ra);
    __syncthreads();
    for (int n = 0; n < 32; ++n) {
        const unsigned char* buf = lds + (n & 1) * SC_BUF;
        if (n + 1 < 32) scan_put(lds + ((n + 1) & 1) * SC_BUF, tid, ra);
        if (n + 2 < 32) scan_fetch(items + (size_t)(n + 2) * DITEM, tid, ra);
        if (wid < 4) {
            const float gam = GAM[n];
            bf16x8 Sb[4][2];
#pragma unroll
            for (int d = 0; d < 4; ++d) { Sb[d][0] = pack8(Sacc[d], 0); Sb[d][1] = pack8(Sacc[d], 1); }
            bf16x8 Vb[2][2];
#pragma unroll
            for (int mb = 0; mb < 2; ++mb) {
                f32x16 t;
#pragma unroll
                for (int i = 0; i < 16; ++i) t[i] = 0.f;
#pragma unroll
                for (int d = 0; d < 4; ++d)
#pragma unroll
                    for (int s = 0; s < 2; ++s) t = MFMA32(lda8(buf + SC_W, 32 * mb + r, 32 * d + 16 * s + 4 * hh, 264), Sb[d][s], t);
                f32x16 vn;
#pragma unroll
                for (int g = 0; g < 4; ++g) {
                    const u32x2 uu = *(const u32x2*)(buf + SC_UT + (c0 + r) * 136 + (32 * mb + 8 * g + 4 * hh) * 2);
                    vn[4 * g] = bf_lo(uu.x) - t[4 * g]; vn[4 * g + 1] = bf_hi(uu.x) - t[4 * g + 1]; vn[4 * g + 2] = bf_lo(uu.y) - t[4 * g + 2]; vn[4 * g + 3] = bf_hi(uu.y) - t[4 * g + 3];
                }
                Vb[mb][0] = pack8(vn, 0); Vb[mb][1] = pack8(vn, 1);
            }
#pragma unroll
            for (int mb = 0; mb < 2; ++mb) {
                f32x16 o;
#pragma unroll
                for (int i = 0; i < 16; ++i) o[i] = 0.f;
#pragma unroll
                for (int d = 0; d < 4; ++d)
#pragma unroll
                    for (int s = 0; s < 2; ++s) o = MFMA32(lda8(buf + SC_QG, 32 * mb + r, 32 * d + 16 * s + 4 * hh, 264), Sb[d][s], o);
#pragma unroll
                for (int jb = 0; jb <= mb; ++jb)
#pragma unroll
                    for (int s = 0; s < 2; ++s) o = MFMA32(lda8(buf + SC_QKM, 32 * mb + r, 32 * jb + 16 * s + 4 * hh, 136), Vb[jb][s], o);
                float* op = ORAW + ((size_t)b * 2048 + n * 64 + 32 * mb + 4 * hh) * 1024 + h * 128 + c0 + r;
#pragma unroll
                for (int i = 0; i < 16; ++i) op[(size_t)((i & 3) + 8 * (i >> 2)) * 1024] = o[i];
            }
#pragma unroll
            for (int d = 0; d < 4; ++d) {
#pragma unroll
                for (int i = 0; i < 16; ++i) Sacc[d][i] *= gam;
#pragma unroll
                for (int jb = 0; jb < 2; ++jb)
#pragma unroll
                    for (int s = 0; s < 2; ++s) Sacc[d] = MFMA32(lda8(buf + SC_KDT, 32 * d + r, 32 * jb + 16 * s + 4 * hh, 136), Vb[jb][s], Sacc[d]);
            }
        }
        __syncthreads();
    }
    if (wid < 4) {
        float* sp = p.out + O_S_P + ((size_t)bh * 128 + 4 * hh) * 128 + c0 + r;
#pragma unroll
        for (int d = 0; d < 4; ++d)
#pragma unroll
            for (int i = 0; i < 16; ++i) __builtin_nontemporal_store(Sacc[d][i], sp + (size_t)(32 * d + (i & 3) + 8 * (i >> 2)) * 128);
    }
}

DI void sample_phase(const Params& p, unsigned char* lds, int first, int stride) {
    int tid = threadIdx.x; asm volatile("" : "+v"(tid));
    const int wid = tid >> 6, lane = tid & 63;
    float* qS = (float*)lds; float* kS = qS + 1024; float* vS = kS + 1024; float* gS = vS + 1024; float* bS = gS + 8;
    float* red = (float*)(lds + 16384);
    float* ored = (float*)(lds + 32768);
    const bf16_t* PJ = (const bf16_t*)(p.ws + OFF_BIG); const float* AB = (const float*)(p.ws + OFF_AB);
    float* ORAW = (float*)(p.ws + OFF_ORAW);
    const int hl = wid >> 2, tok = wid & 3, cs = wid & 3, c4 = lane & 31, dh = lane >> 5;
    for (int item = first; item < 512; item += stride) {
        const int s = item >> 2, hp = item & 3, h = 2 * hp + hl, cb = h * 128 + 2 * lane;
        f32x2 hv[4][3]; unsigned pv[4][3]; f32x2 wv[4][3];
#pragma unroll
        for (int j = 0; j < 4; ++j) {
            const int idx = tok + j; const bool hist = idx < 3;
            const float* sp = p.state_conv_qkv + ((size_t)s * 3 + (hist ? idx : 0)) * 3072 + cb;
            const bf16_t* rp = PJ + (size_t)(MP + s * 4 + (hist ? 0 : idx - 3)) * NPROJ + 3072 + cb;
#pragma unroll
            for (int sg = 0; sg < 3; ++sg) { hv[j][sg] = *(const f32x2*)(sp + sg * 1024); pv[j][sg] = *(const unsigned*)(rp + sg * 1024); wv[j][sg] = *(const f32x2*)(p.conv_qkv_w + j * 3072 + sg * 1024 + cb); }
        }
        const size_t abrow = (size_t)MP + s * 4 + tok;
        const float ab_a = AB[abrow * 16 + h], ab_b = AB[abrow * 16 + 8 + h], alog = p.a_log[h], dtb = p.dt_bias[h];
        const float* Sin = p.state_delta + ((size_t)(s * 8 + h) * 128 + 32 * cs + 16 * dh) * 128 + 4 * c4;
        f32x4 S[16];
#pragma unroll
        for (int i = 0; i < 16; ++i) S[i] = __builtin_nontemporal_load((const f32x4*)(Sin + (size_t)i * 128));
        asm volatile("" ::: "memory");
        {
            float y[3][2];
#pragma unroll
            for (int sg = 0; sg < 3; ++sg) { float a0 = 0.f, a1 = 0.f;
#pragma unroll
                for (int j = 0; j < 4; ++j) { const bool hist = (tok + j) < 3; const float x0 = hist ? hv[j][sg].x : bf_lo(pv[j][sg]), x1 = hist ? hv[j][sg].y : bf_hi(pv[j][sg]);
                    a0 += wv[j][sg].x * x0; a1 += wv[j][sg].y * x1; }
                y[sg][0] = siluf_(a0); y[sg][1] = siluf_(a1); }
            const float sq = wave_sum(y[0][0] * y[0][0] + y[0][1] * y[0][1]), sk = wave_sum(y[1][0] * y[1][0] + y[1][1] * y[1][1]);
            const float rq = rsqrtf(sq + EPS) * 0.08838834764831845f, rk = rsqrtf(sk + EPS);
            const int o = (hl * 4 + tok) * 128 + 2 * lane;
            *(f32x2*)(qS + o) = (f32x2){y[0][0] * rq, y[0][1] * rq}; *(f32x2*)(kS + o) = (f32x2){y[1][0] * rk, y[1][1] * rk}; *(f32x2*)(vS + o) = (f32x2){y[2][0], y[2][1]};
            if (lane == 0) { gS[hl * 4 + tok] = -__expf(alog) * softplusf_(ab_a + dtb); bS[hl * 4 + tok] = sigmoidf_(ab_b); }
        }
        __syncthreads();
#pragma unroll
        for (int tk = 0; tk < 4; ++tk) {
            const float eg = __expf(gS[hl * 4 + tk]), bt = bS[hl * 4 + tk];
            const float* kp = kS + (hl * 4 + tk) * 128 + 32 * cs + 16 * dh; const float* qp = qS + (hl * 4 + tk) * 128 + 32 * cs + 16 * dh;
            f32x4 kv[4];
#pragma unroll
            for (int i4 = 0; i4 < 4; ++i4) kv[i4] = *(const f32x4*)(kp + 4 * i4);
            f32x4 rp = {0.f, 0.f, 0.f, 0.f};
#pragma unroll
            for (int i = 0; i < 16; ++i) rp += S[i] * kv[i >> 2][i & 3];
#pragma unroll
            for (int j = 0; j < 4; ++j) rp[j] += __shfl_xor(rp[j], 32);
            float* rb = red + ((tk * 2 + hl) * 4) * 128;
            if (dh == 0) *(f32x4*)(rb + cs * 128 + 4 * c4) = rp;
            __syncthreads();
            const f32x4 rr = (*(const f32x4*)(rb + 4 * c4) + *(const f32x4*)(rb + 128 + 4 * c4)) + (*(const f32x4*)(rb + 256 + 4 * c4) + *(const f32x4*)(rb + 384 + 4 * c4));
            const f32x4 vv = *(const f32x4*)(vS + (hl * 4 + tk) * 128 + 4 * c4);
            f32x4 vn;
#pragma unroll
            for (int j = 0; j < 4; ++j) vn[j] = bt * (vv[j] - eg * rr[j]);
            f32x4 qv[4];
#pragma unroll
            for (int i4 = 0; i4 < 4; ++i4) qv[i4] = *(const f32x4*)(qp + 4 * i4);
            f32x4 op = {0.f, 0.f, 0.f, 0.f};
#pragma unroll
            for (int i = 0; i < 16; ++i) { S[i] = S[i] * eg + vn * kv[i >> 2][i & 3]; op += S[i] * qv[i >> 2][i & 3]; }
#pragma unroll
            for (int j = 0; j < 4; ++j) op[j] += __shfl_xor(op[j], 32);
            if (dh == 0) *(f32x4*)(ored + ((tk * 2 + hl) * 4 + cs) * 128 + 4 * c4) = op;
        }
        float* Sout = p.out + O_S_S + ((size_t)(s * 8 + h) * 128 + 32 * cs + 16 * dh) * 128 + 4 * c4;
#pragma unroll
        for (int i = 0; i < 16; ++i) __builtin_nontemporal_store(S[i], (f32x4*)(Sout + (size_t)i * 128));
        __syncthreads();
        {
            const int o0 = tid * 2, tkk = o0 >> 8, hh2 = (o0 >> 7) & 1, cc = o0 & 127;
            const float* ob = ored + ((tkk * 2 + hh2) * 4) * 128 + cc;
            const f32x2 v = (*(const f32x2*)ob + *(const f32x2*)(ob + 128)) + (*(const f32x2*)(ob + 256) + *(const f32x2*)(ob + 384));
            *(f32x2*)(ORAW + ((size_t)MP + s * 4 + tkk) * 1024 + (2 * hp + hh2) * 128 + cc) = v;
        }
        __syncthreads();
    }
}

DI void gated_norm_phase(const Params& p) {
    const int tid = otid(), lane = tid & 63, gw = blockIdx.x * 8 + (tid >> 6), nw = gridDim.x * 8;
    const float* ORAW = (const float*)(p.ws + OFF_ORAW); const bf16_t* PJ = (const bf16_t*)(p.ws + OFF_BIG); bf16_t* YC = (bf16_t*)(p.ws + OFF_YC);
    for (int row = gw; row < MT; row += nw) {
        f32x4 o[4]; float ss = 0.f;
#pragma unroll
        for (int i = 0; i < 4; ++i) { o[i] = __builtin_nontemporal_load((const f32x4*)(ORAW + (size_t)row * 1024 + 16 * lane + 4 * i)); ss += o[i][0] * o[i][0] + o[i][1] * o[i][1] + o[i][2] * o[i][2] + o[i][3] * o[i][3]; }
        ss += __shfl_xor(ss, 1); ss += __shfl_xor(ss, 2); ss += __shfl_xor(ss, 4);
        const float rr = rsqrtf(ss * (1.0f / 128.0f) + EPS);
        const u32x4 z0 = *(const u32x4*)(PJ + (size_t)row * NPROJ + 6144 + 16 * lane), z1 = *(const u32x4*)(PJ + (size_t)row * NPROJ + 6144 + 16 * lane + 8);
        float y[16];
#pragma unroll
        for (int e = 0; e < 16; ++e) {
            const unsigned zz = e < 8 ? z0[e >> 1] : z1[(e - 8) >> 1];
            const float z = (e & 1) ? bf_hi(zz) : bf_lo(zz);
            y[e] = o[e >> 2][e & 3] * rr * p.dn_norm[(16 * lane + e) & 127] * siluf_(z);
        }
        u32x4 w0, w1; w0.x = pk_bf16(y[0], y[1]); w0.y = pk_bf16(y[2], y[3]); w0.z = pk_bf16(y[4], y[5]); w0.w = pk_bf16(y[6], y[7]);
        w1.x = pk_bf16(y[8], y[9]); w1.y = pk_bf16(y[10], y[11]); w1.z = pk_bf16(y[12], y[13]); w1.w = pk_bf16(y[14], y[15]);
        *(u32x4*)(YC + (size_t)row * DM + 1024 + 16 * lane) = w0; *(u32x4*)(YC + (size_t)row * DM + 1024 + 16 * lane + 8) = w1;
    }
}

#define XB_TMO      128
#define XB_XCNT(j)  (256  + 64 * (j))
#define XB_XSUB(j)  (1280 + 64 * (j))
#define XB_XGEN(j)  (2304 + 64 * (j))
#define XB_TOP      3328
#define XB_TOPGEN   3392
#define XCD_BAR_WORDS 3456
#define XB_SPIN_CAP (1u << 22)
DI unsigned xb_ld(unsigned* p)              { return __hip_atomic_load(p, __ATOMIC_RELAXED, __HIP_MEMORY_SCOPE_AGENT); }
DI unsigned xb_add(unsigned* p, unsigned v) { return __hip_atomic_fetch_add(p, v, __ATOMIC_RELAXED, __HIP_MEMORY_SCOPE_AGENT); }
DI unsigned xb_xcc_id() { return (unsigned)__builtin_amdgcn_s_getreg((3 << 11) | 20) & 0xFu; }
#define XB_SPIN(cond, bar) do { unsigned _sp = 0; while (cond) { __builtin_amdgcn_s_sleep(1); \
    if ((++_sp & 255u) == 0u) { if (xb_ld(&(bar)[XB_TMO])) break; if (_sp > XB_SPIN_CAP) { atomicAdd(&(bar)[XB_TMO], 1u); break; } } } } while (0)
struct XcdBarrier { unsigned* bar; unsigned x; volatile LAS unsigned* st; };
DI XcdBarrier xcd_barrier_post(unsigned* bar, volatile LAS unsigned* st) {
    XcdBarrier b; b.bar = bar; b.x = xb_xcc_id(); b.st = st;
    if (threadIdx.x == 0) (void)xb_add(&bar[XB_XCNT(b.x)], 1u);
    return b;
}
DI void xcd_barrier_complete(unsigned* bar, unsigned x, unsigned& nloc, unsigned& nx) {
    const unsigned G = gridDim.x * gridDim.y * gridDim.z;
    unsigned sum, cnt, mine, sp = 0u;
    for (;;) {
        sum = 0u; cnt = 0u; mine = 0u;
#pragma unroll
        for (unsigned j = 0; j < 16; ++j) { const unsigned c = xb_ld(&bar[XB_XCNT(j)]); sum += c; cnt += (c > 0u) ? 1u : 0u; mine = (j == x) ? c : mine; }
        if (sum == G) break;
        __builtin_amdgcn_s_sleep(1);
        if ((++sp & 255u) == 0u) { if (xb_ld(&bar[XB_TMO])) break; if (sp > XB_SPIN_CAP) { atomicAdd(&bar[XB_TMO], 1u); break; } }
    }
    nloc = mine > 0u ? mine : 1u; nx = cnt > 0u ? cnt : 1u;
}
DI void xcd_barrier(const XcdBarrier& b) {
    asm volatile("s_waitcnt vmcnt(0)" ::: "memory");
    __syncthreads();
    if (threadIdx.x == 0) {
        unsigned* bar = b.bar;
        __builtin_amdgcn_s_waitcnt(0);
        unsigned nloc = b.st[0], nx = b.st[1];
        if (nloc == 0u) { xcd_barrier_complete(bar, b.x, nloc, nx); b.st[0] = nloc; b.st[1] = nx; }
        const unsigned old = xb_add(&bar[XB_XSUB(b.x)], 1u);
        const unsigned gen = old / nloc;
        if (old + 1u == (gen + 1u) * nloc) {
            __builtin_amdgcn_fence(__ATOMIC_RELEASE, "agent");
            asm volatile("s_waitcnt vmcnt(0)" ::: "memory");
            const unsigned og = xb_add(&bar[XB_TOP], 1u);
            const unsigned tg = og / nx;
            if (og + 1u == (tg + 1u) * nx) xb_add(&bar[XB_TOPGEN], 1u);
            else XB_SPIN(xb_ld(&bar[XB_TOPGEN]) == tg, bar);
            __builtin_amdgcn_fence(__ATOMIC_ACQUIRE, "agent");
            xb_add(&bar[XB_XGEN(b.x)], 1u);
            asm volatile("s_waitcnt vmcnt(0)" ::: "memory");
        } else {
            XB_SPIN(xb_ld(&bar[XB_XGEN(b.x)]) == gen, bar);
            __builtin_amdgcn_fence(__ATOMIC_ACQUIRE, "agent");
            asm volatile("s_waitcnt vmcnt(0)" ::: "memory");
        }
    }
    __syncthreads();
}

__global__ void __launch_bounds__(512, 2) fwd_megakernel(Params p) {
    extern __shared__ __attribute__((aligned(16))) unsigned char shm[];
    cg::grid_group grid = cg::this_grid();
    LAS unsigned char* lds = (LAS unsigned char*)shm;
    unsigned char* ws = p.ws;
    if (threadIdx.x == 0) { *(volatile LAS unsigned*)(lds + LDS_MAIN) = 0u; *(volatile LAS unsigned*)(lds + LDS_MAIN + 4) = 0u; }
    __syncthreads();
    if (blockIdx.x == 0) { unsigned* bw = (unsigned*)(ws + OFF_BAR); for (int i = threadIdx.x; i < XCD_BAR_WORDS; i += 512) __hip_atomic_store(bw + i, 0u, __ATOMIC_RELAXED, __HIP_MEMORY_SCOPE_AGENT); }
    grid.sync();
    const XcdBarrier xb = xcd_barrier_post((unsigned*)(ws + OFF_BAR), (volatile LAS unsigned*)(lds + LDS_MAIN));
    bf16_t* H = (bf16_t*)(ws + OFF_H); bf16_t* YC = (bf16_t*)(ws + OFF_YC); bf16_t* BIG = (bf16_t*)(ws + OFF_BIG); bf16_t* Y = (bf16_t*)(ws + OFF_Y);
    DUP(1) {
        conv_phase(p, (unsigned*)shm, 0, CT_P0 + 234, (int)blockIdx.x, (int)gridDim.x);
        bf16_t* PBF = (bf16_t*)(ws + OFF_PBF);
        for (int it = blockIdx.x * 512 + otid(); it < MT * DPLE / 4; it += gridDim.x * 512) {
            const int e = it * 4; const float* sp = e < MP * DPLE ? p.p_prompt + e : p.p_sample + (e - MP * DPLE);
            const f32x4 v = __builtin_nontemporal_load((const f32x4*)sp); u32x2 w; w.x = pk_bf16(v[0], v[1]); w.y = pk_bf16(v[2], v[3]); *(u32x2*)(PBF + e) = w;
        }
        row_phase(p, 0);
    }
    xcd_barrier(xb);
    DUP(2) run_gemm(lds, H, (const bf16_t*)(ws + OFF_WGU1), MT, 11264, 2048, pg8::EpiSwiglu{BIG});
    tail_conv(p, (unsigned*)shm, 34 * 44, CT_P0 + 234, CT_WD1);
    xcd_barrier(xb);
    DUP(3) run_gemm(lds, BIG, (const bf16_t*)(ws + OFF_WD1), MP, 2048, 5632, pg8::EpiY{Y, DM});
    DUP(4) small_gemm<0>(shm, BIG + (size_t)MP * FF, (const bf16_t*)(ws + OFF_WD1), 5632, Y + (size_t)MP * DM);
    xcd_barrier(xb);
    row_phase(p, 1);
    xcd_barrier(xb);
    DUP(5) run_gemm(lds, H, (const bf16_t*)(ws + OFF_WIN), MT, NINP, 2048, pg8::EpiProj{BIG, (float*)(ws + OFF_AB)});
    tail_conv(p, (unsigned*)shm, 34 * 29, CT_WD1, CT_MISC);
    xcd_barrier(xb);
    prep_phase(p, shm);
    xcd_barrier(xb);
    DUP(8) { if (blockIdx.x < 32) scan_phase(p, shm); else { sample_phase(p, shm, (int)blockIdx.x - 32, (int)gridDim.x - 32); mixer_a_phase(p);
             conv_phase(p, (unsigned*)shm, CT_MISC, CONV_TILES, (int)blockIdx.x - 32, (int)gridDim.x - 32); } }
    XDUP(9) { if (blockIdx.x < 32) scan_phase(p, shm); }
    XDUP(15) { if (blockIdx.x >= 32) sample_phase(p, shm, (int)blockIdx.x - 32, (int)gridDim.x - 32); }
    XDUP(16) { if (blockIdx.x >= 32) mixer_a_phase(p); }
    xcd_barrier(xb);
    DUP(10) gated_norm_phase(p);
    XDUP(11) { xcd_barrier(xb); xcd_barrier(xb); xcd_barrier(xb); xcd_barrier(xb); xcd_barrier(xb); }
    xcd_barrier(xb);
    run_gemm(lds, YC, (const bf16_t*)(ws + OFF_WOUT), MP, 2048, 2048, pg8::EpiY{Y, DM});
    small_gemm<0>(shm, YC + (size_t)MP * DM, (const bf16_t*)(ws + OFF_WOUT), 2048, Y + (size_t)MP * DM);
    xcd_barrier(xb);
    row_phase(p, 2);
    XDUP(13) { xcd_barrier(xb); row_phase(p, 2, true); row_phase(p, 2, true); }
    xcd_barrier(xb);
    run_gemm(lds, H, (const bf16_t*)(ws + OFF_WGU2), MT, 11264, 2048, pg8::EpiSwiglu{BIG});
    xcd_barrier(xb);
    run_gemm(lds, BIG, (const bf16_t*)(ws + OFF_WD2), MP, 2048, 5632, pg8::EpiY{Y, DM});
    small_gemm<0>(shm, BIG + (size_t)MP * FF, (const bf16_t*)(ws + OFF_WD2), 5632, Y + (size_t)MP * DM);
    xcd_barrier(xb);
    row_phase(p, 3);
    xcd_barrier(xb);
    run_gemm(lds, (const bf16_t*)(ws + OFF_PBF), (const bf16_t*)(ws + OFF_WPP), MP, 2048, 256, pg8::EpiY{Y, DM});
    run_gemm(lds, H, (const bf16_t*)(ws + OFF_WPG), MP, 2048, 2048, pg8::EpiGate{Y, DM});
    small_gemm<0>(shm, (const bf16_t*)(ws + OFF_PBF) + (size_t)MP * DPLE, (const bf16_t*)(ws + OFF_WPP), 256, Y + (size_t)MP * DM);
    small_gemm<1>(shm, H + (size_t)MP * DM, (const bf16_t*)(ws + OFF_WPG), 2048, Y + (size_t)MP * DM);
    xcd_barrier(xb);
    row_phase(p, 4);
}

extern "C" void kernel_launch(void* const* d_in, const int* in_sizes, int n_in, void* d_out, int out_size, void* d_ws, size_t ws_size, hipStream_t stream) {
    static int grid_blocks = 0;
    if (grid_blocks == 0) {
        if (n_in != 30 || ws_size < WS_END || out_size != 36614144) { fprintf(stderr, "kernel_launch: unexpected shapes (n_in %d, ws %zu need %zu, out %d)\n", n_in, ws_size, (size_t)WS_END, out_size); grid_blocks = -1; return; }
        int dev = 0, cus = 0, per_cu = 0;
        hipGetDevice(&dev);
        hipDeviceGetAttribute(&cus, hipDeviceAttributeMultiprocessorCount, dev);
        if (hipFuncSetAttribute((const void*)fwd_megakernel, hipFuncAttributeMaxDynamicSharedMemorySize, LDS_BYTES) != hipSuccess) { fprintf(stderr, "kernel_launch: hipFuncSetAttribute failed\n"); grid_blocks = -1; return; }
        hipOccupancyMaxActiveBlocksPerMultiprocessor(&per_cu, (const void*)fwd_megakernel, 512, LDS_BYTES);
        if (per_cu < 1) { fprintf(stderr, "kernel_launch: occupancy query says %d blocks/CU\n", per_cu); per_cu = 1; }
        if (cus < 256) { fprintf(stderr, "kernel_launch: built for a 256-CU device, found %d CUs; nothing launched\n", cus); grid_blocks = -1; return; }
        grid_blocks = 256;
    }
    if (grid_blocks < 0) return;
    Params p{};
    const float** pp = (const float**)&p;
    for (int i = 0; i < 30; ++i) pp[i] = (const float*)d_in[i];
    p.out = (float*)d_out; p.ws = (unsigned char*)d_ws;
    void* args[] = {&p};
    hipError_t e = hipLaunchCooperativeKernel((const void*)fwd_megakernel, dim3(grid_blocks), dim3(512), args, LDS_BYTES, stream);
    if (e != hipSuccess) fprintf(stderr, "cooperative launch failed: %s (grid %d)\n", hipGetErrorString(e), grid_blocks);
}
```
